# Optimizing an MI355X kernel written in HIP

```python
import jax, jax.numpy as jnp
from jax import lax
import numpy as np


D_MODEL = 1024
BATCH = 16
SEQ = 256
DEPTH = 1
DEC_BATCH = 8
DEC_SEQ = 1024
PAST_LEN = 512

GRID_W = 64
CHUNK = 128
N_DIR = 2
H_RET = 4
DK_RET = 128
DV_RET = 256
H_M = 4
DH_M = 128
CONV_W = 3
D_FF = 2816
ROPE_BASE = 10000.0
EPS = 1e-6
GN_EPS = 1e-5
RET_QK = H_RET * DK_RET
RET_V = H_RET * DV_RET
M_W = H_M * DH_M
D_IN = 2 * RET_QK + 2 * RET_V + 4 * M_W + 2 * N_DIR * H_M + N_DIR * D_MODEL

kernel_name = 'bidir_retention_mlstm_diffusion_step'


def _rmsnorm(x, g):
    xf = x.astype(jnp.float32)
    y = xf * lax.rsqrt(jnp.mean(xf * xf, axis=-1, keepdims=True) + EPS)
    return (y * g.astype(jnp.float32)).astype(x.dtype)


def _modulate(u, shift, scale):
    return u * (1 + scale) + shift


def _swiglu(u, w1, w3, w2):
    return (jax.nn.silu(u @ w1) * (u @ w3)) @ w2


def _head_norm(h, g):
    mu = jnp.mean(h, axis=-1, keepdims=True)
    hc = h - mu
    y = hc * lax.rsqrt(jnp.mean(hc * hc, axis=-1, keepdims=True) + GN_EPS)
    B, L, H, d = h.shape
    return y.reshape(B, L, H * d) * g.astype(jnp.float32)


def _short_conv(x, w, b):
    L = x.shape[1]
    pad = CONV_W // 2
    xp = jnp.pad(x, ((0, 0), (pad, CONV_W - 1 - pad), (0, 0)))
    y = b
    for j in range(CONV_W):
        y = y + w[j] * xp[:, j:j + L]
    return y


def _axial_rope(L):
    rows = L // GRID_W
    r = jnp.repeat(jnp.arange(rows, dtype=jnp.float32), GRID_W)
    col = (jnp.arange(L) % GRID_W).astype(jnp.float32)
    n_f = DK_RET // 4
    freqs = ROPE_BASE ** (-jnp.arange(n_f, dtype=jnp.float32) / n_f)
    ang = jnp.concatenate([r[:, None] * freqs, col[:, None] * freqs], axis=-1)
    return jnp.cos(ang), jnp.sin(ang)


def _apply_rope(x, cos, sin):
    half = x.shape[-1] // 2
    x1, x2 = x[..., :half], x[..., half:]
    c = cos[None, :, None, :]
    s = sin[None, :, None, :]
    return jnp.concatenate([x1 * c - x2 * s, x2 * c + x1 * s], axis=-1)


def _split_cols(proj):
    sizes = [RET_QK, RET_QK, RET_V, RET_V, M_W, M_W, M_W, M_W, N_DIR * H_M, N_DIR * H_M, N_DIR * D_MODEL]
    offs = [int(o) for o in np.cumsum(sizes)[:-1]]
    return jnp.split(proj, offs, axis=-1)


def _flip(a, d):
    return jnp.flip(a, axis=1) if d == 1 else a


def _retention_dir(q, k, v, lg, s0):
    B, L, H, dk = q.shape
    dv = v.shape[-1]
    N = L // CHUNK
    qc = q.reshape(B, N, CHUNK, H, dk)
    kc = k.reshape(B, N, CHUNK, H, dk)
    vc = v.reshape(B, N, CHUNK, H, dv)
    pos = jnp.arange(CHUNK, dtype=jnp.float32)
    diff = pos[:, None] - pos[None, :]
    mask = diff >= 0
    e = diff[None] * lg[:, None, None]
    dmat = jnp.where(mask, jnp.exp(jnp.where(mask, e, 0.0)), 0.0)
    scores = jnp.einsum('bnihd,bnjhd->bnhij', qc, kc) * dmat
    intra = jnp.einsum('bnhij,bnjhe->bnihe', scores, vc)
    wk = jnp.exp((CHUNK - 1 - pos)[:, None] * lg[None, :])
    kv = jnp.einsum('bnjhd,jh,bnjhe->bnhde', kc, wk, vc)
    g_chunk = jnp.exp(CHUNK * lg)[:, None, None]

    def step(s, kv_n):
        return g_chunk * s + kv_n, s

    s_fin, s_prev = lax.scan(step, s0, jnp.moveaxis(kv, 1, 0))
    s_prev = jnp.moveaxis(s_prev, 0, 1)
    wq = jnp.exp((pos + 1)[:, None] * lg[None, :])
    cross = jnp.einsum('bnihd,ih,bnhde->bnihe', qc, wq, s_prev)
    return (intra + cross).reshape(B, L, H, dv), s_fin


def _mlstm_dir(q, k, v, ig, lf, c0, n0, m0):
    B, L, H, d = q.shape
    N = L // CHUNK
    qc = q.reshape(B, N, CHUNK, H, d)
    kc = k.reshape(B, N, CHUNK, H, d)
    vc = v.reshape(B, N, CHUNK, H, d)
    igc = jnp.swapaxes(ig.reshape(B, N, CHUNK, H), 2, 3)
    b = jnp.cumsum(jnp.swapaxes(lf.reshape(B, N, CHUNK, H), 2, 3), axis=-1)
    b_last = b[..., -1]
    pos = jnp.arange(CHUNK)
    mask = pos[:, None] >= pos[None, :]
    dlog = jnp.where(mask, b[..., :, None] - b[..., None, :] + igc[..., None, :], -jnp.inf)
    g = b_last[..., None] - b + igc
    m_loc = jnp.max(g, axis=-1)
    w = jnp.exp(g - m_loc[..., None])
    c_loc = jnp.einsum('bnhj,bnjhv,bnjhk->bnhvk', w, vc, kc)
    n_loc = jnp.einsum('bnhj,bnjhk->bnhk', w, kc)

    def step(carry, xs):
        cs, ns, ms = carry
        bl, ml, cl, nl = xs
        m_new = jnp.maximum(bl + ms, ml)
        a1 = jnp.exp(bl + ms - m_new)
        a2 = jnp.exp(ml - m_new)
        c_new = a1[..., None, None] * cs + a2[..., None, None] * cl
        n_new = a1[..., None] * ns + a2[..., None] * nl
        return (c_new, n_new, m_new), (cs, ns, ms)

    xs = (jnp.moveaxis(b_last, 1, 0), jnp.moveaxis(m_loc, 1, 0), jnp.moveaxis(c_loc, 1, 0), jnp.moveaxis(n_loc, 1, 0))
    fin, prev = lax.scan(step, (c0, n0, m0), xs)
    c_prev, n_prev, m_prev = (jnp.moveaxis(a, 0, 1) for a in prev)
    lin = b + m_prev[..., None]
    m_i = jnp.maximum(jnp.max(dlog, axis=-1), lin)
    s = jnp.einsum('bnihk,bnjhk->bnhij', qc, kc) * jnp.exp(dlog - m_i[..., None])
    w_int = jnp.exp(lin - m_i)
    num = jnp.einsum('bnhij,bnjhv->bnihv', s, vc) + jnp.einsum('bnihk,bnhvk->bnihv', qc, c_prev) * jnp.swapaxes(w_int, 2, 3)[..., None]
    den = jnp.sum(s, axis=-1) + jnp.einsum('bnihk,bnhk->bnhi', qc, n_prev) * w_int
    denom = jnp.maximum(jnp.abs(den), jnp.exp(-m_i))
    h = num / jnp.swapaxes(denom, 2, 3)[..., None]
    return h.reshape(B, L, H, d), fin


def _mixer(u, p, s0, rope):
    f32 = jnp.float32
    B, L, _ = u.shape
    dt = u.dtype
    rq, rk, rv, rg, mq, mk, mv, mo, mi, mf, bg = _split_cols(u @ p['w_in'])
    ret_s0, c0, n0, m0 = s0
    rq = rq.astype(f32).reshape(B, L, H_RET, DK_RET)
    rk = rk.astype(f32).reshape(B, L, H_RET, DK_RET) * DK_RET ** -0.5
    rv = rv.astype(f32).reshape(B, L, H_RET, DV_RET)
    if rope is not None:
        rq = _apply_rope(rq, rope[0], rope[1])
        rk = _apply_rope(rk, rope[0], rope[1])
    lg = jax.nn.log_sigmoid(p['ret_decay_logit'].astype(f32))
    r_outs, r_fins = [], []
    for d in range(N_DIR):
        o, sf = _retention_dir(_flip(rq, d), _flip(rk, d), _flip(rv, d), lg[d], ret_s0[:, d])
        r_outs.append(_flip(o, d))
        r_fins.append(sf)
    r = _head_norm(r_outs[0] + r_outs[1], p['ret_gn']) * jax.nn.silu(rg.astype(f32))
    ret_branch = r.astype(dt) @ p['w_ret_up']
    qk = jax.nn.silu(_short_conv(jnp.concatenate([mq, mk], axis=-1), p['conv_w'], p['conv_b']))
    mq = qk[..., :M_W].astype(f32).reshape(B, L, H_M, DH_M)
    mk = qk[..., M_W:].astype(f32).reshape(B, L, H_M, DH_M) * DH_M ** -0.5
    mv = mv.astype(f32).reshape(B, L, H_M, DH_M)
    ig = (mi + p['b_igate']).astype(f32).reshape(B, L, N_DIR, H_M)
    lf = jax.nn.log_sigmoid((mf + p['b_fgate']).astype(f32)).reshape(B, L, N_DIR, H_M)
    m_outs, c_fins, n_fins, m_fins = [], [], [], []
    for d in range(N_DIR):
        h, (cf, nf, mfin) = _mlstm_dir(_flip(mq, d), _flip(mk, d), _flip(mv, d), _flip(ig[:, :, d], d),
                                       _flip(lf[:, :, d], d), c0[:, d], n0[:, d], m0[:, d])
        m_outs.append(_flip(h, d))
        c_fins.append(cf)
        n_fins.append(nf)
        m_fins.append(mfin)
    hm = jax.nn.sigmoid(mo.astype(f32)).reshape(B, L, H_M, DH_M) * (m_outs[0] + m_outs[1])
    m_branch = _head_norm(hm, p['m_gn']).astype(dt) @ p['w_m_up']
    gates = jax.nn.sigmoid(bg.astype(f32)).reshape(B, L, N_DIR, D_MODEL)
    merged = gates[:, :, 0] * ret_branch.astype(f32) + gates[:, :, 1] * m_branch.astype(f32)
    fin = (jnp.stack(r_fins, axis=1), jnp.stack(c_fins, axis=1), jnp.stack(n_fins, axis=1), jnp.stack(m_fins, axis=1))
    return merged.astype(dt) @ p['w_out'], fin


def _layer(x, mod, p, s0, rope):
    sh1, sc1, g1, sh2, sc2, g2, sh3, sc3, g3 = jnp.split(mod, 9, axis=-1)
    x = x + 0.5 * g1 * _swiglu(_modulate(_rmsnorm(x, p['norm_ffn1']), sh1, sc1), p['w1_ffn1'], p['w3_ffn1'], p['w2_ffn1'])
    y, fin = _mixer(_modulate(_rmsnorm(x, p['norm_mix']), sh2, sc2), p, s0, rope)
    x = x + g2 * y
    x = x + 0.5 * g3 * _swiglu(_modulate(_rmsnorm(x, p['norm_ffn2']), sh3, sc3), p['w1_ffn2'], p['w3_ffn2'], p['w2_ffn2'])
    return x, fin


def setup_inputs(seed: int = 0) -> dict:
    key = jax.random.key(seed)
    ks = iter(jax.random.split(key, 40))
    f32 = jnp.float32

    def nrm(shape, scale):
        return scale * jax.random.normal(next(ks), shape, f32)

    gam = 1.0 - 2.0 ** (-5.0 - jnp.arange(H_RET, dtype=f32))
    ret_logit0 = jnp.log(gam) - jnp.log1p(-gam)
    fb = jnp.linspace(3.0, 6.0, H_M, dtype=f32)
    fbias0 = jnp.concatenate([fb, fb])
    return {
        'x_prompt': nrm((BATCH, SEQ, D_MODEL), 1.0),
        'x_sample': nrm((DEC_BATCH, DEC_SEQ, D_MODEL), 1.0),
        'c': nrm((DEC_BATCH, D_MODEL), 1.0),
        'state_ret': nrm((DEC_BATCH, DEPTH, N_DIR, H_RET, DK_RET, DV_RET), 0.3),
        'state_mlstm_C': nrm((DEC_BATCH, DEPTH, N_DIR, H_M, DH_M, DH_M), 0.3),
        'state_mlstm_n': nrm((DEC_BATCH, DEPTH, N_DIR, H_M, DH_M), 0.3),
        'state_mlstm_m': nrm((DEC_BATCH, DEPTH, N_DIR, H_M), 0.5),
        'c_ctx': nrm((D_MODEL,), 1.0),
        'w_ada': nrm((DEPTH, D_MODEL, 9 * D_MODEL), D_MODEL ** -0.5),
        'b_ada': nrm((DEPTH, 9 * D_MODEL), 0.02),
        'norm_ffn1': 1.0 + nrm((DEPTH, D_MODEL), 0.02),
        'w1_ffn1': nrm((DEPTH, D_MODEL, D_FF), D_MODEL ** -0.5),
        'w3_ffn1': nrm((DEPTH, D_MODEL, D_FF), D_MODEL ** -0.5),
        'w2_ffn1': nrm((DEPTH, D_FF, D_MODEL), D_FF ** -0.5),
        'norm_mix': 1.0 + nrm((DEPTH, D_MODEL), 0.02),
        'w_in': nrm((DEPTH, D_MODEL, D_IN), D_MODEL ** -0.5),
        'conv_w': nrm((DEPTH, CONV_W, 2 * M_W), CONV_W ** -0.5),
        'conv_b': nrm((DEPTH, 2 * M_W), 0.02),
        'ret_decay_logit': ret_logit0[None, None, :] + nrm((DEPTH, N_DIR, H_RET), 0.01),
        'b_igate': nrm((DEPTH, N_DIR * H_M), 0.1),
        'b_fgate': fbias0[None, :] + nrm((DEPTH, N_DIR * H_M), 0.1),
        'ret_gn': 1.0 + nrm((DEPTH, RET_V), 0.02),
        'm_gn': 1.0 + nrm((DEPTH, M_W), 0.02),
        'w_ret_up': nrm((DEPTH, RET_V, D_MODEL), RET_V ** -0.5),
        'w_m_up': nrm((DEPTH, M_W, D_MODEL), M_W ** -0.5),
        'w_out': nrm((DEPTH, D_MODEL, D_MODEL), D_MODEL ** -0.5),
        'norm_ffn2': 1.0 + nrm((DEPTH, D_MODEL), 0.02),
        'w1_ffn2': nrm((DEPTH, D_MODEL, D_FF), D_MODEL ** -0.5),
        'w3_ffn2': nrm((DEPTH, D_MODEL, D_FF), D_MODEL ** -0.5),
        'w2_ffn2': nrm((DEPTH, D_FF, D_MODEL), D_FF ** -0.5),
        'norm_final': 1.0 + nrm((D_MODEL,), 0.02),
    }


def reference(x_prompt, x_sample, c, state_ret, state_mlstm_C, state_mlstm_n, state_mlstm_m, c_ctx,
              w_ada, b_ada, norm_ffn1, w1_ffn1, w3_ffn1, w2_ffn1, norm_mix, w_in, conv_w, conv_b,
              ret_decay_logit, b_igate, b_fgate, ret_gn, m_gn, w_ret_up, w_m_up, w_out,
              norm_ffn2, w1_ffn2, w3_ffn2, w2_ffn2, norm_final):
    f32 = jnp.float32
    bp = x_prompt.shape[0]
    rope = _axial_rope(x_sample.shape[1])
    zero_state = (jnp.zeros((bp, N_DIR, H_RET, DK_RET, DV_RET), f32),
                  jnp.zeros((bp, N_DIR, H_M, DH_M, DH_M), f32),
                  jnp.zeros((bp, N_DIR, H_M, DH_M), f32),
                  jnp.zeros((bp, N_DIR, H_M), f32))
    xp, xs = x_prompt, x_sample
    fins = []
    for l in range(DEPTH):
        p = {'norm_ffn1': norm_ffn1[l], 'w1_ffn1': w1_ffn1[l], 'w3_ffn1': w3_ffn1[l], 'w2_ffn1': w2_ffn1[l],
             'norm_mix': norm_mix[l], 'w_in': w_in[l], 'conv_w': conv_w[l], 'conv_b': conv_b[l],
             'ret_decay_logit': ret_decay_logit[l], 'b_igate': b_igate[l], 'b_fgate': b_fgate[l],
             'ret_gn': ret_gn[l], 'm_gn': m_gn[l], 'w_ret_up': w_ret_up[l], 'w_m_up': w_m_up[l], 'w_out': w_out[l],
             'norm_ffn2': norm_ffn2[l], 'w1_ffn2': w1_ffn2[l], 'w3_ffn2': w3_ffn2[l], 'w2_ffn2': w2_ffn2[l]}
        mod_ctx = (jax.nn.silu(c_ctx) @ w_ada[l] + b_ada[l])[None, None, :]
        mod_lat = (jax.nn.silu(c) @ w_ada[l] + b_ada[l])[:, None, :]
        xp, fin = _layer(xp, mod_ctx, p, zero_state, None)
        lat_state = (state_ret[:, l].astype(f32), state_mlstm_C[:, l].astype(f32),
                     state_mlstm_n[:, l].astype(f32), state_mlstm_m[:, l].astype(f32))
        xs, _ = _layer(xs, mod_lat, p, lat_state, rope)
        fins.append(fin)
    dt = x_prompt.dtype
    y_prompt = _rmsnorm(xp, norm_final)
    y_sample = _rmsnorm(xs, norm_final)
    new_state_ret = jnp.stack([f[0] for f in fins], axis=1).astype(dt)
    new_state_mlstm_C = jnp.stack([f[1] for f in fins], axis=1).astype(dt)
    new_state_mlstm_n = jnp.stack([f[2] for f in fins], axis=1).astype(dt)
    new_state_mlstm_m = jnp.stack([f[3] for f in fins], axis=1).astype(dt)
    return (y_prompt, y_sample, new_state_ret, new_state_mlstm_C, new_state_mlstm_n, new_state_mlstm_m)
```

```cpp
#include <hip/hip_runtime.h>
#include <cstdio>
#include <cstdint>
#define MK_PER_PHASE 0
namespace pg8 {
#define PG8_LAS __attribute__((address_space(3)))
typedef unsigned short bf16_t;
typedef short bf16x8 __attribute__((ext_vector_type(8)));
typedef float f32x4 __attribute__((ext_vector_type(4)));
typedef unsigned u32x4 __attribute__((ext_vector_type(4)));
constexpr int BM = 256, BK = 64, HALF = 128, HTB = HALF * BK * 2  , STAGE_BYTES = 8 * HTB, NXCD = 8, WGM = 8;

__host__ __device__ __forceinline__ int lds_byte(int r, int c) { const int st = (r >> 4) * 2 + (c >> 5), rr = r & 15, cc = c & 31, ob = rr * 64 + cc * 2; return st * 1024 + (ob ^ (((ob >> 9) & 1) << 5)); }
__host__ __device__ __forceinline__ void stage_rc(int b, int& R, int& C) { const int st = b / 1024, sb = b % 1024, swz = sb ^ (((sb >> 9) & 1) << 5); R = (st >> 1) * 16 + swz / 64; C = (st & 1) * 32 + (swz % 64) / 2; }
__host__ __device__ __forceinline__ int perm32(int rho) { const int n = rho >> 4, i = rho & 15; return 8 * (i >> 2) + 4 * n + (i & 3); }

struct Unit { int pm, pn; };
struct Gemm { const bf16_t* A; const bf16_t* Bt; int M, N, K, lda; };

struct StaticOrder {
    int nM, nN, nwg, G, c;
    __host__ __device__ void init(int M, int N, int G_, int c_) { nM = M / BM; nN = N / BM; nwg = nM * nN; G = G_; c = c_; }
    __host__ __device__ bool next(int i, Unit& u) const {
        const long L = (long)i * G + c; if (L >= nwg) return false;
        int wgid = (int)L; { const int q = nwg / NXCD, r = nwg % NXCD, xcd = wgid % NXCD, off = wgid / NXCD; wgid = (xcd < r ? xcd * (q + 1) : r * (q + 1) + (xcd - r) * q) + off; }
        const int nig = WGM * nN, gid = wgid / nig, fm = gid * WGM, gsz = (nM - fm) < WGM ? (nM - fm) : WGM;
        u.pm = fm + ((wgid % nig) % gsz); u.pn = (wgid % nig) / gsz; return true;
    }
    __device__ __forceinline__ void a_ready(const Unit&) const {}
    __device__ __forceinline__ void done(const Unit&) const {}
};

__device__ __forceinline__ unsigned cvt_pk_bf16(float lo, float hi) { unsigned r; asm volatile("v_cvt_pk_bf16_f32 %0, %1, %2" : "=v"(r) : "v"(lo), "v"(hi)); return r; }
template <class Epi, class Sched, bool ALIGN_EPI = false, bool SP2 = false>
__device__ __forceinline__ void gemm_phase(PG8_LAS unsigned char* lds, const Gemm g, const Sched& S, const Epi& E) {
    int tid_l = threadIdx.x; asm volatile("" : "+v"(tid_l)); const int tid = tid_l, wid = __builtin_amdgcn_readfirstlane(tid >> 6), lane = tid & 63, wr = wid >> 2, wc = wid & 3, fr = lane & 15, fq = lane >> 4;
    const int K = g.K, nt = K / BK;
    unsigned voffA[2], voffB[2];
#pragma unroll
    for (int i = 0; i < 2; ++i) { int R, C; stage_rc(tid * 16 + i * 8192, R, C); const int Rb = Epi::PERM ? ((R & ~31) + perm32(R & 31)) : R;
        voffA[i] = (unsigned)(R * g.lda + C) * 2u; voffB[i] = (unsigned)(Rb * K + C) * 2u; }
    const size_t kstep = (size_t)(BK * 2);
    const size_t hstep = (size_t)HALF * K * 2;
    const size_t tstep = 2 * hstep; const size_t hstepA = (size_t)HALF * g.lda * 2, tstepA = 2 * hstepA;
    const unsigned ldsw = (unsigned)wid * 1024u;
    const int aoff = lds_byte(wr * 64 + fr, fq * 8), boff = lds_byte(wc * 32 + fr, fq * 8);
#define PG8_SA(b, h) (((b) * 2 + (h)) * HTB)
#define PG8_SB(b, h) ((4 + (b) * 2 + (h)) * HTB)
#define PG8_STAGE(bufoff, gbase, voff) do { _Pragma("unroll") for (int _i = 0; _i < 2; ++_i) \
        __builtin_amdgcn_global_load_lds((const unsigned*)((const char*)(gbase) + (voff)[_i]), (PG8_LAS unsigned*)(lds + (bufoff) + ldsw + _i * 8192), 16, 0, 0); } while (0)
#define PG8_LDA(dst, b, h) do { _Pragma("unroll") for (int m = 0; m < 4; ++m) _Pragma("unroll") for (int k = 0; k < 2; ++k) dst[m][k] = *(const PG8_LAS bf16x8*)(lds + PG8_SA(b, h) + aoff + m * 2048 + k * 1024); } while (0)
#define PG8_LDB(dst, b, h) do { _Pragma("unroll") for (int n = 0; n < 2; ++n) _Pragma("unroll") for (int k = 0; k < 2; ++k) dst[n][k] = *(const PG8_LAS bf16x8*)(lds + PG8_SB(b, h) + boff + n * 2048 + k * 1024); } while (0)
#define PG8_MMA(ai, bj, At, Bt) do { __builtin_amdgcn_s_setprio(1); _Pragma("unroll") for (int m = 0; m < 4; ++m) _Pragma("unroll") for (int n = 0; n < 2; ++n) _Pragma("unroll") for (int k = 0; k < 2; ++k) \
        acc[ai][bj][m][n] = __builtin_amdgcn_mfma_f32_16x16x32_bf16(Bt[n][k], At[m][k], acc[ai][bj][m][n], 0, 0, 0); __builtin_amdgcn_s_setprio(0); } while (0)
#define PG8_WAIT_V(n) asm volatile("s_waitcnt vmcnt(" #n ")" ::: "memory")
#define PG8_WAIT_L(n) asm volatile("s_waitcnt lgkmcnt(" #n ")" ::: "memory")
#define PG8_BAR __builtin_amdgcn_s_barrier()
#define PG8_SCHED __builtin_amdgcn_sched_barrier(0)
    Unit cur, nxt; int ui = 0;
    if (!S.next(0, cur)) return;
    f32x4 acc[2][2][4][2];
#pragma unroll
    for (int a = 0; a < 2; ++a)
#pragma unroll
        for (int b = 0; b < 2; ++b)
#pragma unroll
            for (int m = 0; m < 4; ++m)
#pragma unroll
                for (int n = 0; n < 2; ++n) acc[a][b][m][n] = (f32x4){0.f, 0.f, 0.f, 0.f};
    bf16x8 At[4][2], B0[2][2], B1[2][2];
    const char* cA = (const char*)g.A + (size_t)cur.pm * tstepA; const char* cB = (const char*)g.Bt + (size_t)cur.pn * tstep;
    S.a_ready(cur);
    if constexpr (SP2) {
        PG8_STAGE(PG8_SB(0, 0), cB, voffB); PG8_STAGE(PG8_SB(0, 1), cB + hstep, voffB); PG8_STAGE(PG8_SA(0, 0), cA, voffA); PG8_STAGE(PG8_SA(0, 1), cA + hstepA, voffA);
        if (wr == 1) PG8_BAR;
        PG8_WAIT_V(2); PG8_BAR;
        PG8_STAGE(PG8_SB(1, 0), cB + kstep, voffB); PG8_STAGE(PG8_SA(1, 0), cA + kstep, voffA); PG8_STAGE(PG8_SB(1, 1), cB + hstep + kstep, voffB);
        PG8_WAIT_V(6); PG8_BAR;
    } else {
        PG8_STAGE(PG8_SB(0, 0), cB, voffB); PG8_STAGE(PG8_SA(0, 0), cA, voffA); PG8_STAGE(PG8_SB(0, 1), cB + hstep, voffB); PG8_STAGE(PG8_SA(0, 1), cA + hstepA, voffA);
        if (wr == 1) PG8_BAR;
        PG8_WAIT_V(4); PG8_BAR;
        PG8_STAGE(PG8_SB(1, 0), cB + kstep, voffB); PG8_STAGE(PG8_SA(1, 0), cA + kstep, voffA); PG8_STAGE(PG8_SB(1, 1), cB + hstep + kstep, voffB);
        PG8_WAIT_V(6); PG8_BAR;
    }
    for (;;) {
        const bool has_next = S.next(ui + 1, nxt);
        const char* nA = has_next ? (const char*)g.A + (size_t)nxt.pm * tstepA : cA; const char* nB = has_next ? (const char*)g.Bt + (size_t)nxt.pn * tstep : cB;
        for (int t = 0; t < nt; t += 2) {
            const bool last = (t == nt - 2);
            const char* a1 = cA + (size_t)(t + 1) * kstep;
            const char* a2 = last ? nA : cA + (size_t)(t + 2) * kstep; const char* b2 = last ? nB : cB + (size_t)(t + 2) * kstep;
            const char* a3 = a2 + kstep; const char* b3 = b2 + kstep;
            if (last && has_next) S.a_ready(nxt);
            if constexpr (SP2) {
            PG8_LDB(B0, 0, 0); PG8_LDB(B1, 0, 1); PG8_SCHED; PG8_LDA(At, 0, 0); PG8_STAGE(PG8_SA(1, 1), a1 + hstepA, voffA);
            PG8_WAIT_V(8); PG8_WAIT_L(0); PG8_BAR; PG8_MMA(0, 0, At, B0); PG8_MMA(0, 1, At, B1); PG8_BAR; PG8_SCHED;
            PG8_LDA(At, 0, 1); PG8_STAGE(PG8_SB(0, 0), b2, voffB); PG8_STAGE(PG8_SB(0, 1), b2 + hstep, voffB); PG8_STAGE(PG8_SA(0, 0), a2, voffA);
            PG8_WAIT_V(8); PG8_WAIT_L(0); PG8_BAR; PG8_MMA(1, 0, At, B0); PG8_MMA(1, 1, At, B1); PG8_BAR; PG8_SCHED;
            PG8_LDB(B0, 1, 0); PG8_LDB(B1, 1, 1); PG8_SCHED; PG8_LDA(At, 1, 0); PG8_STAGE(PG8_SA(0, 1), a2 + hstepA, voffA);
            PG8_WAIT_V(8); PG8_WAIT_L(0); PG8_BAR; PG8_MMA(0, 0, At, B0); PG8_MMA(0, 1, At, B1); PG8_BAR; PG8_SCHED;
            PG8_LDA(At, 1, 1); PG8_STAGE(PG8_SB(1, 0), b3, voffB); PG8_STAGE(PG8_SB(1, 1), b3 + hstep, voffB); PG8_STAGE(PG8_SA(1, 0), a3, voffA);
            PG8_WAIT_V(8); PG8_WAIT_L(0); PG8_BAR; PG8_MMA(1, 0, At, B0); PG8_MMA(1, 1, At, B1); PG8_BAR; PG8_SCHED;
            } else {
            PG8_LDB(B0, 0, 0); PG8_SCHED; PG8_LDA(At, 0, 0); PG8_STAGE(PG8_SA(1, 1), a1 + hstepA, voffA);
            PG8_WAIT_L(8); PG8_BAR; PG8_WAIT_L(0); PG8_MMA(0, 0, At, B0); PG8_BAR; PG8_SCHED;
            PG8_LDB(B1, 0, 1); PG8_STAGE(PG8_SB(0, 0), b2, voffB);
            PG8_BAR; PG8_WAIT_L(0); PG8_MMA(0, 1, At, B1); PG8_BAR;
            PG8_LDA(At, 0, 1); PG8_STAGE(PG8_SA(0, 0), a2, voffA);
            PG8_BAR; PG8_WAIT_L(0); PG8_MMA(1, 0, At, B0); PG8_BAR; PG8_SCHED;
            PG8_STAGE(PG8_SB(0, 1), b2 + hstep, voffB);
            PG8_WAIT_V(6); PG8_BAR; PG8_MMA(1, 1, At, B1); PG8_BAR;
            PG8_LDB(B0, 1, 0); PG8_SCHED; PG8_LDA(At, 1, 0); PG8_STAGE(PG8_SA(0, 1), a2 + hstepA, voffA);
            PG8_WAIT_L(8); PG8_BAR; PG8_WAIT_L(0); PG8_MMA(0, 0, At, B0); PG8_BAR; PG8_SCHED;
            PG8_LDB(B1, 1, 1); PG8_STAGE(PG8_SB(1, 0), b3, voffB);
            PG8_BAR; PG8_WAIT_L(0); PG8_MMA(0, 1, At, B1); PG8_BAR;
            PG8_LDA(At, 1, 1); PG8_STAGE(PG8_SA(1, 0), a3, voffA);
            PG8_BAR; PG8_WAIT_L(0); PG8_MMA(1, 0, At, B0); PG8_BAR; PG8_SCHED;
            PG8_STAGE(PG8_SB(1, 1), b3 + hstep, voffB);
            PG8_WAIT_V(6); PG8_BAR; PG8_MMA(1, 1, At, B1); PG8_BAR;
            }
        }
        if constexpr (ALIGN_EPI) { if (wr == 0) PG8_BAR; }
        if constexpr (!Epi::AFTER_DRAIN) { E(acc, cur, wr, wc, fr, fq); S.done(cur); }
        if (!has_next) break;
#pragma unroll
        for (int a = 0; a < 2; ++a)
#pragma unroll
            for (int b = 0; b < 2; ++b)
#pragma unroll
                for (int m = 0; m < 4; ++m)
#pragma unroll
                    for (int n = 0; n < 2; ++n) acc[a][b][m][n] = (f32x4){0.f, 0.f, 0.f, 0.f};
        cur = nxt; cA = nA; cB = nB; ++ui;
        if constexpr (ALIGN_EPI) { if (wr == 1) PG8_BAR; }
    }
    PG8_WAIT_V(0);
    if constexpr (!ALIGN_EPI) { if (wr == 0) PG8_BAR; }
    PG8_BAR;
    if constexpr (Epi::AFTER_DRAIN) { E.fused(acc, cur, wr, wc, fr, fq, lds, wid, lane); S.done(cur); }
#undef PG8_SA
#undef PG8_SB
#undef PG8_STAGE
#undef PG8_LDA
#undef PG8_LDB
#undef PG8_MMA
#undef PG8_WAIT_V
#undef PG8_WAIT_L
#undef PG8_BAR
#undef PG8_SCHED
}
}

constexpr int D = 1024, NCTX = 4096, MROWS = 12288, FF = 2816;
constexpr int CH = 128, NCHUNK = 96, NHEAD = 4;
constexpr int PA_LD = 4096;
constexpr int C_RQ = 0, C_RK = 512, C_RV = 1024, C_MQ = 2048, C_MK = 2560, C_MV = 3072, C_MO = 3584;
constexpr int MODW = 9216;
constexpr float EPS_RMS = 1e-6f, EPS_GN = 1e-5f;
constexpr size_t OUT_Y = 0, OUT_SRET = (size_t)MROWS * D, OUT_SC = OUT_SRET + 16ull * 2 * 4 * 128 * 256, OUT_SN = OUT_SC + 16ull * 2 * 4 * 128 * 128, OUT_SM = OUT_SN + 16ull * 2 * 4 * 128, OUT_END = OUT_SM + 128;
constexpr size_t MiB = 1u << 20, KiB = 1024;
constexpr size_t WS_CTL = 0, CTL_ZERO_BYTES = 64 * KiB;
constexpr size_t WS_MOD = 1 * MiB;
constexpr size_t WS_WG = 1 * MiB + 384 * KiB;
constexpr size_t WS_ROPE = 2 * MiB;
constexpr size_t WS_IG = 2 * MiB + 512 * KiB;
constexpr size_t WS_LF = WS_IG + 384 * KiB;
constexpr size_t WS_MN = WS_LF + 384 * KiB;
constexpr size_t WS_MS = WS_MN + 384 * KiB;
constexpr size_t WS_W13A = 4 * MiB, WS_W2A = 15 * MiB, WS_W13B = 20 * MiB + 512 * KiB, WS_W2B = 31 * MiB + 512 * KiB;
constexpr size_t WS_WIN = 37 * MiB, WS_WR = 51 * MiB, WS_WM = 53 * MiB, WS_WO = 54 * MiB;
constexpr size_t WS_U = 56 * MiB;
constexpr size_t WS_BIG = 80 * MiB;
constexpr size_t WS_H = WS_BIG;
constexpr size_t WS_PA = WS_BIG;
constexpr size_t WS_RS = 176 * MiB;
constexpr size_t WS_MC = 224 * MiB;
constexpr size_t WS_BG = WS_RS;
constexpr size_t WS_T1 = WS_MC;
constexpr size_t WS_END = 248 * MiB;
static_assert(WS_MS + 16 * KiB <= WS_W13A, "ws map");
constexpr int CW_BAR = 1024;

constexpr int LDS_BYTES = 147456;
constexpr int RING_BYTES = 131072;
constexpr int MISC_OFF = LDS_BYTES - 256;

#define GAS __attribute__((address_space(1)))
#define LAS __attribute__((address_space(3)))
typedef unsigned short bf16;
typedef unsigned v4u __attribute__((ext_vector_type(4)));
typedef unsigned v2u __attribute__((ext_vector_type(2)));
typedef float f32x4 __attribute__((ext_vector_type(4)));
typedef GAS unsigned gu32;
#define RLX_AGENT __ATOMIC_RELAXED, __HIP_MEMORY_SCOPE_AGENT
#define LDS_WAIT() asm volatile("s_waitcnt lgkmcnt(0)" ::: "memory")
#define VM_WAIT() asm volatile("s_waitcnt vmcnt(0)" ::: "memory")
__device__ __forceinline__ unsigned f2bf(float f) { unsigned u = __builtin_bit_cast(unsigned, f); return (u + 0x7fffu + ((u >> 16) & 1u)) >> 16; }
__device__ __forceinline__ unsigned pk2(float lo, float hi) { return f2bf(lo) | (f2bf(hi) << 16); }
__device__ __forceinline__ float bf2f(unsigned short b) { return __builtin_bit_cast(float, (unsigned)b << 16); }
__device__ __forceinline__ float bflo(unsigned w) { return __builtin_bit_cast(float, w << 16); }
__device__ __forceinline__ float bfhi(unsigned w) { return __builtin_bit_cast(float, w & 0xffff0000u); }
__device__ __forceinline__ float silu_f(float x) { return x / (1.f + __expf(-x)); }
__device__ __forceinline__ float sigmoid_f(float x) { return 1.f / (1.f + __expf(-x)); }
__device__ __forceinline__ float logsigmoid_f(float x) { return fminf(x, 0.f) - log1pf(expf(-fabsf(x))); }
__device__ __forceinline__ float wave_sum(float v) {
#pragma unroll
    for (int o = 1; o < 64; o <<= 1) v += __shfl_xor(v, o);
    return v;
}
#define XB_TMO      128
#define XB_XCNT(j)  (256  + 64 * (j))
#define XB_XSUB(j)  (1280 + 64 * (j))
#define XB_XGEN(j)  (2304 + 64 * (j))
#define XB_TOP      3328
#define XB_TOPGEN   3392
#define XCD_BAR_WORDS 3456
#define XB_SPIN_CAP (1u << 18)

__device__ __forceinline__ unsigned xb_ld(unsigned* p)              { return __hip_atomic_load(p, __ATOMIC_RELAXED, __HIP_MEMORY_SCOPE_AGENT); }
__device__ __forceinline__ unsigned xb_add(unsigned* p, unsigned v) { return __hip_atomic_fetch_add(p, v, __ATOMIC_RELAXED, __HIP_MEMORY_SCOPE_AGENT); }
__device__ __forceinline__ unsigned xb_xcc_id() { return (unsigned)__builtin_amdgcn_s_getreg((3 << 11) | 20) & 0xFu; }
#define XB_SPIN(cond, bar) do { unsigned _sp = 0; while (cond) { __builtin_amdgcn_s_sleep(1); \
    if ((++_sp & 255u) == 0u) { if (xb_ld(&(bar)[XB_TMO])) break; if (_sp > XB_SPIN_CAP) { atomicAdd(&(bar)[XB_TMO], 1u); break; } } } } while (0)

struct XcdBarrier {
    unsigned* bar; unsigned x;
    volatile LAS unsigned* st;
};

__device__ __forceinline__ XcdBarrier xcd_barrier_post(unsigned* bar, volatile LAS unsigned* st) {
    XcdBarrier b; b.bar = bar; b.x = xb_xcc_id(); b.st = st;
    if (threadIdx.x == 0) (void)xb_add(&bar[XB_XCNT(b.x)], 1u);
    return b;
}
__device__ __forceinline__ void xcd_barrier_complete(unsigned* bar, unsigned x, unsigned& nloc, unsigned& nx) {
    const unsigned G = gridDim.x * gridDim.y * gridDim.z;
    unsigned sum, cnt, mine, sp = 0u;
    for (;;) {
        sum = 0u; cnt = 0u; mine = 0u;
#pragma unroll
        for (unsigned j = 0; j < 16; ++j) { const unsigned c = xb_ld(&bar[XB_XCNT(j)]); sum += c; cnt += (c > 0u) ? 1u : 0u; mine = (j == x) ? c : mine; }
        if (sum == G) break;
        __builtin_amdgcn_s_sleep(1);
        if ((++sp & 255u) == 0u) { if (xb_ld(&bar[XB_TMO])) break; if (sp > XB_SPIN_CAP) { atomicAdd(&bar[XB_TMO], 1u); break; } }
    }
    nloc = mine > 0u ? mine : 1u; nx = cnt > 0u ? cnt : 1u;
}

__device__ __forceinline__ void xcd_barrier(const XcdBarrier& b) {
    asm volatile("s_waitcnt vmcnt(0)" ::: "memory");
    __syncthreads();
    if (threadIdx.x == 0) {
        unsigned* bar = b.bar;
        __builtin_amdgcn_s_waitcnt(0);
        unsigned nloc = b.st[0], nx = b.st[1];
        if (nloc == 0u) { xcd_barrier_complete(bar, b.x, nloc, nx); b.st[0] = nloc; b.st[1] = nx; }
        const unsigned old = xb_add(&bar[XB_XSUB(b.x)], 1u);
        const unsigned gen = old / nloc;
        if (old + 1u == (gen + 1u) * nloc) {
            __builtin_amdgcn_fence(__ATOMIC_RELEASE, "agent");
            asm volatile("s_waitcnt vmcnt(0)" ::: "memory");
            const unsigned og = xb_add(&bar[XB_TOP], 1u);
            const unsigned tg = og / nx;
            if (og + 1u == (tg + 1u) * nx) xb_add(&bar[XB_TOPGEN], 1u);
            else XB_SPIN(xb_ld(&bar[XB_TOPGEN]) == tg, bar);
            __builtin_amdgcn_fence(__ATOMIC_ACQUIRE, "agent");
            xb_add(&bar[XB_XGEN(b.x)], 1u);
            asm volatile("s_waitcnt vmcnt(0)" ::: "memory");
        } else {
            XB_SPIN(xb_ld(&bar[XB_XGEN(b.x)]) == gen, bar);
            __builtin_amdgcn_fence(__ATOMIC_ACQUIRE, "agent");
            asm volatile("s_waitcnt vmcnt(0)" ::: "memory");
        }
    }
    __syncthreads();
}

struct Args { const float* in[31]; float* out; unsigned char* ws; int ph_lo, ph_hi; };
enum { I_XP = 0, I_XS, I_C, I_SRET, I_SC, I_SN, I_SM, I_CCTX, I_WADA, I_BADA, I_NF1, I_W1A, I_W3A, I_W2A, I_NMIX, I_WIN, I_CONVW, I_CONVB,
       I_DECAY, I_BIG, I_BFG, I_RETGN, I_MGN, I_WRUP, I_WMUP, I_WOUT, I_NF2, I_W1B, I_W3B, I_W2B, I_NFIN };

struct Frame {
    unsigned char* lds;
    int tid, lane, wave, G, bid, gw, ngw;
};

__device__ __forceinline__ int mod_row(int row) { return row < NCTX ? 0 : 1 + ((row - NCTX) >> 10); }

__device__ __forceinline__ int rope_perm(int p) { const int s = p >> 6, i = p & 63; return 8 * (i >> 2) + 4 * s + (i & 3); }
template <int MODE>
__device__ __forceinline__ void p0_tr_item(const float* W, int ldw, int col0, int K, int ncols, bf16* WT, int row_off, float* scr, int item, int lane) {
    const int nblk = ncols / 32, kb = item / nblk, nb = item % nblk, k0 = 64 * kb, n0 = 32 * nb;
#pragma unroll 8
    for (int i = 0; i < 32; ++i) { const int kk = 2 * i + (lane >> 5); scr[kk * 33 + (lane & 31)] = W[(size_t)(k0 + kk) * ldw + col0 + n0 + (lane & 31)]; }
    LDS_WAIT(); asm volatile("" ::: "memory");
    const int c = lane & 7;
#pragma unroll
    for (int j = 0; j < 4; ++j) { const int n = (lane >> 3) + 8 * j, nn = n0 + n; const float* s = scr + (8 * c) * 33 + n;
        int drow;
        if (MODE == 0) drow = row_off + nn; else if (MODE == 1) drow = row_off + (nn & ~127) + rope_perm(nn & 127); else drow = row_off + 256 * (nn >> 7) + (nn & 127);
        v4u o; o.x = pk2(s[0 * 33], s[1 * 33]); o.y = pk2(s[2 * 33], s[3 * 33]); o.z = pk2(s[4 * 33], s[5 * 33]); o.w = pk2(s[6 * 33], s[7 * 33]);
        *(v4u*)(WT + (size_t)drow * K + k0 + 8 * c) = o; }
    LDS_WAIT(); asm volatile("" ::: "memory");
}

__device__ __forceinline__ void p0_prologue(const Args& a, const Frame& F) {
    unsigned char* ws = a.ws;
    float* mod = (float*)(ws + WS_MOD);
    if (F.bid < MODW / 64) {
        float* sc = (float*)F.lds;
        float* part = (float*)(F.lds + 40960);
        for (int idx = F.tid; idx < 9 * 1024; idx += 512) { const int r = idx >> 10, k = idx & 1023; const float v = r == 0 ? a.in[I_CCTX][k] : a.in[I_C][(r - 1) * 1024 + k]; sc[idx] = v / (1.f + expf(-v)); }
        __syncthreads();
        const int c0 = 64 * F.bid, k0 = 128 * F.wave; const float* wp = a.in[I_WADA] + (size_t)k0 * MODW + c0 + F.lane;
        float acc[9];
#pragma unroll
        for (int r = 0; r < 9; ++r) acc[r] = 0.f;
#pragma unroll 16
        for (int kk = 0; kk < 128; ++kk) { const float wv = wp[(size_t)kk * MODW];
#pragma unroll
            for (int r = 0; r < 9; ++r) acc[r] += sc[r * 1024 + k0 + kk] * wv; }
#pragma unroll
        for (int r = 0; r < 9; ++r) part[(F.wave * 9 + r) * 64 + F.lane] = acc[r];
        __syncthreads();
        for (int idx = F.tid; idx < 9 * 64; idx += 512) { const int r = idx >> 6, l = idx & 63; float s = 0.f;
#pragma unroll
            for (int w = 0; w < 8; ++w) s += part[(w * 9 + r) * 64 + l];
            mod[r * MODW + c0 + l] = s + a.in[I_BADA][c0 + l]; }
        __syncthreads();
    }
    { float* wg = (float*)(ws + WS_WG); const int gt = F.bid * 512 + F.tid, ngt = F.G * 512;
      for (int idx = gt; idx < 16 * 1024; idx += ngt) { const int c = idx >> 10, k = idx & 1023; wg[idx] = a.in[I_WIN][(size_t)k * 7184 + 5120 + c]; }
      float2* rope = (float2*)(ws + WS_ROPE);
      for (int idx = gt; idx < 1024 * 64; idx += ngt) { const int t = idx >> 6, i = idx & 63, f = i & 31; const float freq = exp2f(-(float)f * (13.287712379549449f / 32.f));
          const float pos = (float)(i < 32 ? (t >> 6) : (t & 63)); const float ang = pos * freq; rope[idx] = make_float2(cosf(ang), sinf(ang)); } }
    float* scr = (float*)(F.lds + F.wave * 16384);
    bf16* W13A = (bf16*)(ws + WS_W13A); bf16* W2A = (bf16*)(ws + WS_W2A); bf16* W13B = (bf16*)(ws + WS_W13B); bf16* W2B = (bf16*)(ws + WS_W2B);
    bf16* WIN = (bf16*)(ws + WS_WIN); bf16* WR = (bf16*)(ws + WS_WR); bf16* WM = (bf16*)(ws + WS_WM); bf16* WO = (bf16*)(ws + WS_WO);
    constexpr int I_UP = 16 * 88, I_DN = 44 * 32, I_512 = 16 * 32, I_1024 = 16 * 64, I_MUP = 8 * 32;
    constexpr int NITEMS = 4 * I_UP + 2 * I_DN + (I_512 + I_512 + I_1024 + I_512 + I_1024) + I_512 + I_MUP + I_512;
    for (int it = F.gw; it < NITEMS; it += F.ngw) {
        int r = it;
        if (r < I_UP) { p0_tr_item<2>(a.in[I_W1A], FF, 0, D, FF, W13A, 0, scr, r, F.lane); continue; } r -= I_UP;
        if (r < I_UP) { p0_tr_item<2>(a.in[I_W3A], FF, 0, D, FF, W13A, 128, scr, r, F.lane); continue; } r -= I_UP;
        if (r < I_DN) { p0_tr_item<0>(a.in[I_W2A], D, 0, FF, D, W2A, 0, scr, r, F.lane); continue; } r -= I_DN;
        if (r < I_UP) { p0_tr_item<2>(a.in[I_W1B], FF, 0, D, FF, W13B, 0, scr, r, F.lane); continue; } r -= I_UP;
        if (r < I_UP) { p0_tr_item<2>(a.in[I_W3B], FF, 0, D, FF, W13B, 128, scr, r, F.lane); continue; } r -= I_UP;
        if (r < I_DN) { p0_tr_item<0>(a.in[I_W2B], D, 0, FF, D, W2B, 0, scr, r, F.lane); continue; } r -= I_DN;
        if (r < I_512) { p0_tr_item<1>(a.in[I_WIN], 7184, 0, D, 1024, WIN, 0, scr, r, F.lane); continue; } r -= I_512;
        if (r < I_512) { p0_tr_item<0>(a.in[I_WIN], 7184, 1024, D, 1024, WIN, 1024, scr, r, F.lane); continue; } r -= I_512;
        if (r < I_1024) { p0_tr_item<0>(a.in[I_WIN], 7184, 3072, D, 2048, WIN, 2048, scr, r, F.lane); continue; } r -= I_1024;
        if (r < I_512) { p0_tr_item<0>(a.in[I_WIN], 7184, 2048, D, 1024, WIN, 4096, scr, r, F.lane); continue; } r -= I_512;
        if (r < I_1024) { p0_tr_item<0>(a.in[I_WIN], 7184, 5136, D, 2048, WIN, 5120, scr, r, F.lane); continue; } r -= I_1024;
        if (r < I_512) { p0_tr_item<0>(a.in[I_WRUP], D, 0, D, D, WR, 0, scr, r, F.lane); continue; } r -= I_512;
        if (r < I_MUP) { p0_tr_item<0>(a.in[I_WMUP], D, 0, 512, D, WM, 0, scr, r, F.lane); continue; } r -= I_MUP;
        p0_tr_item<0>(a.in[I_WOUT], D, 0, D, D, WO, 0, scr, r, F.lane);
    }
}

template <bool GATES>
__device__ __forceinline__ void norm_phase(const Args& a, const Frame& F, const float* x0, const float* x1, const float* nw, int sh_off, int sc_off) {
    const float* mod = (const float*)(a.ws + WS_MOD); bf16* U = (bf16*)(a.ws + WS_U);
    float* wgs = (float*)F.lds;
    if (GATES) { const float* wg = (const float*)(a.ws + WS_WG); for (int i = F.tid; i < 16 * 1024 / 4; i += 512) ((f32x4*)wgs)[i] = ((const f32x4*)wg)[i]; __syncthreads(); }
    f32x4 nwv[4];
#pragma unroll
    for (int j = 0; j < 4; ++j) nwv[j] = ((const f32x4*)nw)[F.lane + 64 * j];
    for (int row = F.gw; row < MROWS; row += F.ngw) {
        const float* xr = row < NCTX ? x0 + (size_t)row * D : x1 + (size_t)(row - NCTX) * D;
        const int mr = mod_row(row); const float* shp = mod + mr * MODW + sh_off; const float* scp = mod + mr * MODW + sc_off;
        f32x4 v[4]; float ss = 0.f;
#pragma unroll
        for (int j = 0; j < 4; ++j) { v[j] = ((const f32x4*)xr)[F.lane + 64 * j]; ss += (v[j].x * v[j].x + v[j].y * v[j].y) + (v[j].z * v[j].z + v[j].w * v[j].w); }
        const float rstd = 1.f / sqrtf(wave_sum(ss) * (1.f / D) + EPS_RMS);
        unsigned long long* o8 = (unsigned long long*)(U + (size_t)row * D) + F.lane;
#pragma unroll
        for (int j = 0; j < 4; ++j) { const f32x4 sh = ((const f32x4*)shp)[F.lane + 64 * j], sc = ((const f32x4*)scp)[F.lane + 64 * j];
            v[j] = v[j] * rstd * nwv[j] * (sc + 1.f) + sh;
            o8[64 * j] = (unsigned long long)pk2(v[j].x, v[j].y) | ((unsigned long long)pk2(v[j].z, v[j].w) << 32); }
        if (GATES) {
            float* IG = (float*)(a.ws + WS_IG); float* LF = (float*)(a.ws + WS_LF); float mine = 0.f;
#pragma unroll 1
            for (int c = 0; c < 16; ++c) { float p = 0.f;
#pragma unroll
                for (int j = 0; j < 4; ++j) { const f32x4 w = ((const f32x4*)(wgs + c * 1024))[F.lane + 64 * j]; p += (v[j].x * w.x + v[j].y * w.y) + (v[j].z * w.z + v[j].w * w.w); }
                p = wave_sum(p); if (F.lane == c) mine = p; }
            if (F.lane < 8) IG[(size_t)row * 8 + F.lane] = mine + a.in[I_BIG][F.lane];
            else if (F.lane < 16) LF[(size_t)row * 8 + F.lane - 8] = logsigmoid_f(mine + a.in[I_BFG][F.lane - 8]);
        }
    }
    if (GATES) __syncthreads();
}
__device__ __forceinline__ void final_norm_phase(const Args& a, const Frame& F) {
    f32x4 nwv[4];
#pragma unroll
    for (int j = 0; j < 4; ++j) nwv[j] = ((const f32x4*)a.in[I_NFIN])[F.lane + 64 * j];
    for (int row = F.gw; row < MROWS; row += F.ngw) {
        f32x4* xr = (f32x4*)(a.out + (size_t)row * D); f32x4 v[4]; float ss = 0.f;
#pragma unroll
        for (int j = 0; j < 4; ++j) { v[j] = xr[F.lane + 64 * j]; ss += (v[j].x * v[j].x + v[j].y * v[j].y) + (v[j].z * v[j].z + v[j].w * v[j].w); }
        const float rstd = 1.f / sqrtf(wave_sum(ss) * (1.f / D) + EPS_RMS);
#pragma unroll
        for (int j = 0; j < 4; ++j) xr[F.lane + 64 * j] = v[j] * rstd * nwv[j];
    }
}

using pg8::f32x4; using pg8::Unit; using pg8::cvt_pk_bf16;
struct EpiSwiGLU {
    static constexpr bool PERM = true, AFTER_DRAIN = false; bf16* H;
    __device__ __forceinline__ void operator()(const pg8::f32x4 (&acc)[2][2][4][2], const Unit& u, int wr, int wc, int fr, int fq) const {
        const int row0 = u.pm * 256 + wr * 64 + fr, col0 = u.pn * 128 + wc * 32 + 8 * fq;
#pragma unroll
        for (int ai = 0; ai < 2; ++ai)
#pragma unroll
            for (int m = 0; m < 4; ++m) { bf16* rowp = H + (size_t)(row0 + ai * 128 + m * 16) * FF + col0;
                const pg8::f32x4 g0 = acc[ai][0][m][0], g1 = acc[ai][0][m][1], u0 = acc[ai][1][m][0], u1 = acc[ai][1][m][1];
                v4u w; w.x = cvt_pk_bf16(silu_f(g0[0]) * u0[0], silu_f(g0[1]) * u0[1]); w.y = cvt_pk_bf16(silu_f(g0[2]) * u0[2], silu_f(g0[3]) * u0[3]);
                w.z = cvt_pk_bf16(silu_f(g1[0]) * u1[0], silu_f(g1[1]) * u1[1]); w.w = cvt_pk_bf16(silu_f(g1[2]) * u1[2], silu_f(g1[3]) * u1[3]);
                *(v4u*)rowp = w; }
    }
};
struct EpiResid {
    static constexpr bool PERM = false, AFTER_DRAIN = false; const float* base0; const float* base1; float* X; const float* gate; float scale;
    __device__ __forceinline__ void operator()(const pg8::f32x4 (&acc)[2][2][4][2], const Unit& u, int wr, int wc, int fr, int fq) const {
        const int row0 = u.pm * 256 + wr * 64 + fr, col0 = u.pn * 256 + wc * 32 + 4 * fq; const int mr = mod_row(u.pm * 256);
        pg8::f32x4 gv[2][2];
#pragma unroll
        for (int bj = 0; bj < 2; ++bj)
#pragma unroll
            for (int n = 0; n < 2; ++n) gv[bj][n] = *(const pg8::f32x4*)(gate + mr * MODW + col0 + bj * 128 + n * 16) * scale;
#pragma unroll
        for (int ai = 0; ai < 2; ++ai)
#pragma unroll
            for (int m = 0; m < 4; ++m) { const int row = row0 + ai * 128 + m * 16;
                const float* bp = (row < NCTX ? base0 + (size_t)row * D : base1 + (size_t)(row - NCTX) * D) + col0; float* xp = X + (size_t)row * D + col0;
#pragma unroll
                for (int bj = 0; bj < 2; ++bj)
#pragma unroll
                    for (int n = 0; n < 2; ++n) { const pg8::f32x4 b = *(const pg8::f32x4*)(bp + bj * 128 + n * 16); *(pg8::f32x4*)(xp + bj * 128 + n * 16) = b + gv[bj][n] * acc[ai][bj][m][n]; } }
    }
};
struct EpiProjA {
    static constexpr bool PERM = true, AFTER_DRAIN = false; bf16* P; const float2* rope;
    __device__ __forceinline__ void operator()(const pg8::f32x4 (&acc)[2][2][4][2], const Unit& u, int wr, int wc, int fr, int fq) const {
        const int row0 = u.pm * 256 + wr * 64 + fr;
        if (u.pn < 4) {
            const bool isk = u.pn >= 2, lat = u.pm >= 16; const float scl = isk ? 0.08838834764831845f : 1.f; const int q4 = 4 * wc + fq;
#pragma unroll
            for (int ai = 0; ai < 2; ++ai)
#pragma unroll
                for (int m = 0; m < 4; ++m) { const int row = row0 + ai * 128 + m * 16; const int t = (row - NCTX) & 1023;
#pragma unroll
                    for (int bj = 0; bj < 2; ++bj) { const int hh = 2 * (u.pn & 1) + bj; bf16* op = P + (size_t)row * PA_LD + (isk ? C_RK : C_RQ) + 128 * hh + 4 * q4;
                        pg8::f32x4 x1 = acc[ai][bj][m][0] * scl, x2 = acc[ai][bj][m][1] * scl;
                        if (lat) { const float2* cs = rope + t * 64 + 4 * q4;
#pragma unroll
                            for (int j = 0; j < 4; ++j) { const float2 c = cs[j]; const float a1 = x1[j], a2 = x2[j]; x1[j] = a1 * c.x - a2 * c.y; x2[j] = a2 * c.x + a1 * c.y; } }
                        v2u w1, w2; w1.x = cvt_pk_bf16(x1[0], x1[1]); w1.y = cvt_pk_bf16(x1[2], x1[3]); w2.x = cvt_pk_bf16(x2[0], x2[1]); w2.y = cvt_pk_bf16(x2[2], x2[3]);
                        *(v2u*)op = w1; *(v2u*)(op + 64) = w2; } }
        } else {
            const bool sg = u.pn >= 14; const int col0 = u.pn * 256 + wc * 32 + 8 * fq;
#pragma unroll
            for (int ai = 0; ai < 2; ++ai)
#pragma unroll
                for (int m = 0; m < 4; ++m) { bf16* rowp = P + (size_t)(row0 + ai * 128 + m * 16) * PA_LD + col0;
#pragma unroll
                    for (int bj = 0; bj < 2; ++bj) { pg8::f32x4 v0 = acc[ai][bj][m][0], v1 = acc[ai][bj][m][1];
                        if (sg) {
#pragma unroll
                            for (int j = 0; j < 4; ++j) { v0[j] = sigmoid_f(v0[j]); v1[j] = sigmoid_f(v1[j]); } }
                        v4u w; w.x = cvt_pk_bf16(v0[0], v0[1]); w.y = cvt_pk_bf16(v0[2], v0[3]); w.z = cvt_pk_bf16(v1[0], v1[1]); w.w = cvt_pk_bf16(v1[2], v1[3]);
                        *(v4u*)(rowp + bj * 128) = w; } }
        }
    }
};
struct EpiProjB {
    static constexpr bool PERM = true, AFTER_DRAIN = false; bf16* P; bf16* BG;
    __device__ __forceinline__ void operator()(const pg8::f32x4 (&acc)[2][2][4][2], const Unit& u, int wr, int wc, int fr, int fq) const {
        const int row0 = u.pm * 256 + wr * 64 + fr;
#pragma unroll
        for (int ai = 0; ai < 2; ++ai)
#pragma unroll
            for (int m = 0; m < 4; ++m) { const int row = row0 + ai * 128 + m * 16;
#pragma unroll
                for (int bj = 0; bj < 2; ++bj) { pg8::f32x4 v0 = acc[ai][bj][m][0], v1 = acc[ai][bj][m][1];
                    if (u.pn < 4) { bf16* p = P + (size_t)row * PA_LD + C_RV + u.pn * 256 + bj * 128 + wc * 32 + 8 * fq; const v4u r = *(const v4u*)p;
                        v4u w; w.x = cvt_pk_bf16(bflo(r.x) * silu_f(v0[0]), bfhi(r.x) * silu_f(v0[1])); w.y = cvt_pk_bf16(bflo(r.y) * silu_f(v0[2]), bfhi(r.y) * silu_f(v0[3]));
                        w.z = cvt_pk_bf16(bflo(r.z) * silu_f(v1[0]), bfhi(r.z) * silu_f(v1[1])); w.w = cvt_pk_bf16(bflo(r.w) * silu_f(v1[2]), bfhi(r.w) * silu_f(v1[3]));
                        *(v4u*)p = w;
                    } else { bf16* p = BG + (size_t)row * 2048 + (u.pn - 4) * 256 + bj * 128 + wc * 32 + 8 * fq;
                        v4u w; w.x = cvt_pk_bf16(sigmoid_f(v0[0]), sigmoid_f(v0[1])); w.y = cvt_pk_bf16(sigmoid_f(v0[2]), sigmoid_f(v0[3]));
                        w.z = cvt_pk_bf16(sigmoid_f(v1[0]), sigmoid_f(v1[1])); w.w = cvt_pk_bf16(sigmoid_f(v1[2]), sigmoid_f(v1[3]));
                        *(v4u*)p = w; } } }
    }
};
template <bool SECOND> struct EpiMerge {
    static constexpr bool PERM = true, AFTER_DRAIN = false; const bf16* BG; bf16* T1; bf16* OUT;
    __device__ __forceinline__ void operator()(const pg8::f32x4 (&acc)[2][2][4][2], const Unit& u, int wr, int wc, int fr, int fq) const {
        const int row0 = u.pm * 256 + wr * 64 + fr;
#pragma unroll
        for (int ai = 0; ai < 2; ++ai)
#pragma unroll
            for (int m = 0; m < 4; ++m) { const int row = row0 + ai * 128 + m * 16;
#pragma unroll
                for (int bj = 0; bj < 2; ++bj) { const int col = u.pn * 256 + bj * 128 + wc * 32 + 8 * fq; const pg8::f32x4 v0 = acc[ai][bj][m][0], v1 = acc[ai][bj][m][1];
                    const v4u g = *(const v4u*)(BG + (size_t)row * 2048 + (SECOND ? 1024 : 0) + col);
                    float o[8] = {bflo(g.x) * v0[0], bfhi(g.x) * v0[1], bflo(g.y) * v0[2], bfhi(g.y) * v0[3], bflo(g.z) * v1[0], bfhi(g.z) * v1[1], bflo(g.w) * v1[2], bfhi(g.w) * v1[3]};
                    if (SECOND) { const v4u t = *(const v4u*)(T1 + (size_t)row * D + col);
                        o[0] += bflo(t.x); o[1] += bfhi(t.x); o[2] += bflo(t.y); o[3] += bfhi(t.y); o[4] += bflo(t.z); o[5] += bfhi(t.z); o[6] += bflo(t.w); o[7] += bfhi(t.w); }
                    v4u w; w.x = cvt_pk_bf16(o[0], o[1]); w.y = cvt_pk_bf16(o[2], o[3]); w.z = cvt_pk_bf16(o[4], o[5]); w.w = cvt_pk_bf16(o[6], o[7]);
                    *(v4u*)((SECOND ? OUT : T1) + (size_t)row * D + col) = w; } }
    }
};

__device__ __forceinline__ void chunk_info(int gc, int& n, int& N) { if (gc < 32) { n = gc & 1; N = 2; } else { n = (gc - 32) & 7; N = 8; } }
__device__ __forceinline__ size_t st_idx(int gc, int h, int dir) { return (size_t)((gc * 4 + h) * 2 + dir); }

__device__ __forceinline__ float conv_silu(const bf16* PA, const float* cw, const float* cb, int row, int col, int ch, bool first, bool last) {
    const bf16* p = PA + (size_t)row * PA_LD + col;
    float y = cb[ch] + cw[1024 + ch] * bf2f(p[0]);
    if (!first) y += cw[ch] * bf2f(p[-PA_LD]);
    if (!last) y += cw[2048 + ch] * bf2f(p[PA_LD]);
    return silu_f(y);
}

__device__ __forceinline__ void p6_scalar(const Args& a, const Frame& F) {
    const bf16* PA = (const bf16*)(a.ws + WS_PA); bf16* RS = (bf16*)(a.ws + WS_RS); bf16* MC = (bf16*)(a.ws + WS_MC);
    float* MN = (float*)(a.ws + WS_MN); float* MS = (float*)(a.ws + WS_MS);
    const float* IG = (const float*)(a.ws + WS_IG); const float* LF = (const float*)(a.ws + WS_LF);
    bf16* K_l = (bf16*)F.lds; bf16* V_l = (bf16*)(F.lds + 32768); float* wf = (float*)(F.lds + 98304); float* wb = wf + 128; float* tmpa = wb + 128; float* tmpb = tmpa + 128; float* scal = tmpb + 128;
    for (int it = F.bid; it < 2 * NCHUNK * 4; it += F.G) {
        const int branch = it / (NCHUNK * 4), gc = (it % (NCHUNK * 4)) >> 2, h = it & 3, row0 = gc * CH; int n, N; chunk_info(gc, n, N);
        __syncthreads();
        if (branch == 0) {
            const float lg0 = logsigmoid_f(a.in[I_DECAY][h]), lg1 = logsigmoid_f(a.in[I_DECAY][4 + h]);
            for (int idx = F.tid; idx < 128 * 128; idx += 512) { const int j = idx >> 7, d = idx & 127; K_l[idx] = PA[(size_t)(row0 + j) * PA_LD + C_RK + h * 128 + d]; }
            for (int idx = F.tid; idx < 128 * 256; idx += 512) { const int j = idx >> 8, e = idx & 255; V_l[idx] = PA[(size_t)(row0 + j) * PA_LD + C_RV + h * 256 + e]; }
            if (F.tid < 128) { wf[F.tid] = expf(lg0 * (float)(127 - F.tid)); wb[F.tid] = expf(lg1 * (float)F.tid); }
            __syncthreads();
            const int d = F.tid & 127, eg = F.tid >> 7;
            for (int e = eg * 64; e < eg * 64 + 64; ++e) { float af = 0.f, ab = 0.f;
                for (int j = 0; j < 128; ++j) { const float p = bf2f(K_l[j * 128 + d]) * bf2f(V_l[j * 256 + e]); af += wf[j] * p; ab += wb[j] * p; }
                RS[st_idx(gc, h, 0) * 32768 + e * 128 + d] = (bf16)f2bf(af); RS[st_idx(gc, h, 1) * 32768 + e * 128 + d] = (bf16)f2bf(ab); }
        } else {
            const float* cw = a.in[I_CONVW]; const float* cb = a.in[I_CONVB];
            for (int idx = F.tid; idx < 128 * 128; idx += 512) { const int j = idx >> 7, d = idx & 127;
                K_l[idx] = (bf16)f2bf(conv_silu(PA, cw, cb, row0 + j, C_MK + h * 128 + d, 512 + h * 128 + d, n == 0 && j == 0, n == N - 1 && j == 127) * 0.08838834764831845f);
                V_l[idx] = PA[(size_t)(row0 + j) * PA_LD + C_MV + h * 128 + d]; }
            if (F.tid < 2) { const int dir = F.tid; float* w = dir ? wb : wf; float* b = dir ? tmpb : tmpa;
                float run = 0.f;
                if (dir == 0) { for (int j = 0; j < 128; ++j) { run += LF[(size_t)(row0 + j) * 8 + h]; b[j] = run; } }
                else { for (int j = 127; j >= 0; --j) { run += LF[(size_t)(row0 + j) * 8 + 4 + h]; b[j] = run; } }
                const float blast = run; float ml = -3.0e38f;
                for (int j = 0; j < 128; ++j) { const float g = blast - b[j] + IG[(size_t)(row0 + j) * 8 + dir * 4 + h]; w[j] = g; ml = fmaxf(ml, g); }
                for (int j = 0; j < 128; ++j) w[j] = expf(w[j] - ml);
                MS[st_idx(gc, h, dir) * 4 + 0] = ml; MS[st_idx(gc, h, dir) * 4 + 1] = blast; }
            __syncthreads();
            const int k = F.tid & 127, vg = F.tid >> 7;
            for (int v = vg * 32; v < vg * 32 + 32; ++v) { float af = 0.f, ab = 0.f;
                for (int j = 0; j < 128; ++j) { const float p = bf2f(K_l[j * 128 + k]) * bf2f(V_l[j * 128 + v]); af += wf[j] * p; ab += wb[j] * p; }
                MC[st_idx(gc, h, 0) * 16384 + v * 128 + k] = (bf16)f2bf(af); MC[st_idx(gc, h, 1) * 16384 + v * 128 + k] = (bf16)f2bf(ab); }
            if (F.tid < 256) { const int dir = F.tid >> 7; const float* w = dir ? wb : wf; float s = 0.f;
                for (int j = 0; j < 128; ++j) s += w[j] * bf2f(K_l[j * 128 + k]);
                MN[st_idx(gc, h, dir) * 128 + k] = s; }
        }
    }
    (void)scal;
}

__device__ __forceinline__ void p7_scalar(const Args& a, const Frame& F) {
    bf16* RS = (bf16*)(a.ws + WS_RS); bf16* MC = (bf16*)(a.ws + WS_MC); float* MN = (float*)(a.ws + WS_MN); float* MS = (float*)(a.ws + WS_MS);
    const int gt = F.bid * 512 + F.tid, ngt = F.G * 512;
    for (long e = gt; e < 24L * 4 * 2 * 32768; e += ngt) {
        const int idx = (int)(e & 32767), sh = (int)(e >> 15), dir = sh & 1, h = (sh >> 1) & 3, s = sh >> 3; const int ev = idx >> 7, d = idx & 127;
        const bool lat = s >= 16; const int N = lat ? 8 : 2, gc0 = lat ? 32 + 8 * (s - 16) : 2 * s;
        const float G = expf(128.f * logsigmoid_f(a.in[I_DECAY][dir * 4 + h]));
        float acc = lat ? a.in[I_SRET][((size_t)(((s - 16) * 2 + dir) * 4 + h)) * 32768 + d * 256 + ev] : 0.f;
        for (int st = 0; st < N; ++st) { const int n = dir ? N - 1 - st : st; bf16* p = RS + st_idx(gc0 + n, h, dir) * 32768 + idx; const float t = bf2f(*p); *p = (bf16)f2bf(acc); acc = G * acc + t; }
        if (!lat) a.out[OUT_SRET + ((size_t)((s * 2 + dir) * 4 + h)) * 32768 + d * 256 + ev] = acc;
    }
    for (long e = gt; e < 24L * 4 * 2 * 16384; e += ngt) {
        const int idx = (int)(e & 16383), sh = (int)(e >> 14), dir = sh & 1, h = (sh >> 1) & 3, s = sh >> 3;
        const bool lat = s >= 16; const int N = lat ? 8 : 2, gc0 = lat ? 32 + 8 * (s - 16) : 2 * s; const int sidx = lat ? ((s - 16) * 2 + dir) * 4 + h : 0;
        float m = lat ? a.in[I_SM][sidx] : 0.f; float C = lat ? a.in[I_SC][(size_t)sidx * 16384 + idx] : 0.f; float nv = (lat && idx < 128) ? a.in[I_SN][sidx * 128 + idx] : 0.f;
        for (int st = 0; st < N; ++st) { const int n = dir ? N - 1 - st : st; const size_t si = st_idx(gc0 + n, h, dir);
            const float ml = MS[si * 4 + 0], bl = MS[si * 4 + 1]; const float mn = fmaxf(bl + m, ml), a1 = expf(bl + m - mn), a2 = expf(ml - mn);
            bf16* p = MC + si * 16384 + idx; const float t = bf2f(*p); *p = (bf16)f2bf(C); C = a1 * C + a2 * t;
            if (idx < 128) { float* q = MN + si * 128 + idx; const float tn = *q; *q = nv; nv = a1 * nv + a2 * tn; }
            if (idx == 0) MS[si * 4 + 2] = m;
            m = mn; }
        if (!lat) { const int o = (s * 2 + dir) * 4 + h; a.out[OUT_SC + (size_t)o * 16384 + idx] = C; if (idx < 128) a.out[OUT_SN + o * 128 + idx] = nv; if (idx == 0) a.out[OUT_SM + o] = m; }
    }
}

template <int BR> __device__ __forceinline__ void p8_scalar(const Args& a, const Frame& F) {
    bf16* PA = (bf16*)(a.ws + WS_PA); const bf16* RS = (const bf16*)(a.ws + WS_RS); const bf16* MC = (const bf16*)(a.ws + WS_MC);
    const float* MN = (const float*)(a.ws + WS_MN); const float* MS = (const float*)(a.ws + WS_MS);
    const float* IG = (const float*)(a.ws + WS_IG); const float* LF = (const float*)(a.ws + WS_LF);
    constexpr int QLD = 130;
    for (int it = F.bid; it < NCHUNK * 4; it += F.G) {
        const int branch = BR, gc = it >> 2, h = it & 3, row0 = gc * CH; int n, N; chunk_info(gc, n, N);
        const bool lat = gc >= 32;
        __syncthreads();
        if (branch == 0) {
            bf16* Q_l = (bf16*)F.lds; bf16* P_l = (bf16*)(F.lds + 33280); bf16* K_l = (bf16*)(F.lds + 66560); bf16* park = K_l;
            float* sml = (float*)(F.lds + 132608); float* ratio = sml; float* wqb = sml + 128; float* red = sml + 256;
            const float lg0 = logsigmoid_f(a.in[I_DECAY][h]), lg1 = logsigmoid_f(a.in[I_DECAY][4 + h]);
            for (int idx = F.tid; idx < 128 * 128; idx += 512) { const int j = idx >> 7, d = idx & 127;
                Q_l[j * QLD + d] = PA[(size_t)(row0 + j) * PA_LD + C_RQ + h * 128 + d]; K_l[j * QLD + d] = PA[(size_t)(row0 + j) * PA_LD + C_RK + h * 128 + d]; }
            if (F.tid < 128) { const float i = (float)F.tid; wqb[F.tid] = expf(lg1 * (128.f - i)); ratio[F.tid] = expf(lg0 * (i + 1.f) - lg1 * (128.f - i)); }
            __syncthreads();
            { const int j = F.tid & 127, g4 = F.tid >> 7;
              for (int i = g4 * 32; i < g4 * 32 + 32; ++i) { float s = 0.f;
                  for (int d = 0; d < 128; ++d) s += bf2f(Q_l[i * QLD + d]) * bf2f(K_l[j * QLD + d]);
                  const float dm = i > j ? expf(lg0 * (float)(i - j)) : (i < j ? expf(lg1 * (float)(j - i)) : 2.f);
                  P_l[i * QLD + j] = (bf16)f2bf(s * dm); } }
            __syncthreads();
            const int e = F.tid & 255, ig2 = F.tid >> 8;
            const bf16* SF = RS + st_idx(gc, h, 0) * 32768 + e * 128; const bf16* SB = RS + st_idx(gc, h, 1) * 32768 + e * 128;
            const bool hasf = lat || n > 0, hasb = lat || n < N - 1;
            for (int rg = 0; rg < 4; ++rg) { const int r0 = ig2 * 64 + rg * 16; float acc[16];
#pragma unroll
                for (int ii = 0; ii < 16; ++ii) acc[ii] = 0.f;
                for (int d = 0; d < 128; ++d) { const float sf = hasf ? bf2f(SF[d]) : 0.f;
#pragma unroll
                    for (int ii = 0; ii < 16; ++ii) acc[ii] += bf2f(Q_l[(r0 + ii) * QLD + d]) * sf; }
#pragma unroll
                for (int ii = 0; ii < 16; ++ii) acc[ii] *= ratio[r0 + ii];
                for (int d = 0; d < 128; ++d) { const float sb = hasb ? bf2f(SB[d]) : 0.f;
#pragma unroll
                    for (int ii = 0; ii < 16; ++ii) acc[ii] += bf2f(Q_l[(r0 + ii) * QLD + d]) * sb; }
#pragma unroll
                for (int ii = 0; ii < 16; ++ii) acc[ii] *= wqb[r0 + ii];
                for (int j = 0; j < 128; ++j) { const float v = bf2f(PA[(size_t)(row0 + j) * PA_LD + C_RV + h * 256 + e]);
#pragma unroll
                    for (int ii = 0; ii < 16; ++ii) acc[ii] += bf2f(P_l[(r0 + ii) * QLD + j]) * v; }
#pragma unroll
                for (int ii = 0; ii < 16; ++ii) { const float s1 = wave_sum(acc[ii]), s2 = wave_sum(acc[ii] * acc[ii]);
                    if (F.lane == 0) { red[((r0 + ii) * 4 + (F.wave & 3)) * 2 + 0] = s1; red[((r0 + ii) * 4 + (F.wave & 3)) * 2 + 1] = s2; }
                    park[(r0 + ii) * 256 + e] = (bf16)f2bf(acc[ii]); }
            }
            __syncthreads();
            const float gn = a.in[I_RETGN][h * 256 + e];
            for (int i = ig2 * 64; i < ig2 * 64 + 64; ++i) { float s1 = 0.f, s2 = 0.f;
#pragma unroll
                for (int w = 0; w < 4; ++w) { s1 += red[(i * 4 + w) * 2]; s2 += red[(i * 4 + w) * 2 + 1]; }
                const float mu = s1 * (1.f / 256.f), var = fmaxf(s2 * (1.f / 256.f) - mu * mu, 0.f);
                PA[(size_t)(row0 + i) * PA_LD + C_RV + h * 256 + e] = (bf16)f2bf((bf2f(park[i * 256 + e]) - mu) * (1.f / sqrtf(var + EPS_GN)) * gn); }
        } else {
            bf16* Q_l = (bf16*)F.lds; bf16* K_l = (bf16*)(F.lds + 33280); float* SM = (float*)(F.lds + 66560);
            float* park = (float*)F.lds;
            float* sml = (float*)(F.lds + 132608); float* lfs = sml; float* igs = sml + 128; float* bs = sml + 256; float* mis = sml + 384; float* wis = sml + 512; float* qns = sml + 640; float* rds = sml + 768; float* red = sml + 896;
            const float* cw = a.in[I_CONVW]; const float* cb = a.in[I_CONVB];
            for (int idx = F.tid; idx < 128 * 128; idx += 512) { const int j = idx >> 7, d = idx & 127; const bool fi = n == 0 && j == 0, la = n == N - 1 && j == 127;
                Q_l[j * QLD + d] = (bf16)f2bf(conv_silu(PA, cw, cb, row0 + j, C_MQ + h * 128 + d, h * 128 + d, fi, la));
                K_l[j * QLD + d] = (bf16)f2bf(conv_silu(PA, cw, cb, row0 + j, C_MK + h * 128 + d, 512 + h * 128 + d, fi, la) * 0.08838834764831845f); }
            const int v = F.tid & 127, ig = F.tid >> 7; float hacc[32];
#pragma unroll
            for (int ii = 0; ii < 32; ++ii) hacc[ii] = 0.f;
            for (int dir = 0; dir < 2; ++dir) {
                const size_t si = st_idx(gc, h, dir); const bool has = lat || (dir ? n < N - 1 : n > 0);
                const float mprev = has ? MS[si * 4 + 2] : 0.f;
                __syncthreads();
                if (F.tid < 128) { lfs[F.tid] = LF[(size_t)(row0 + F.tid) * 8 + dir * 4 + h]; igs[F.tid] = IG[(size_t)(row0 + F.tid) * 8 + dir * 4 + h]; }
                __syncthreads();
                if (F.tid < 128) { const int i = F.tid; float b = 0.f; if (dir == 0) { for (int t = 0; t <= i; ++t) b += lfs[t]; } else { for (int t = 127; t >= i; --t) b += lfs[t]; } bs[i] = b; }
                __syncthreads();
                if (F.tid < 128) { const int i = F.tid; const float bi = bs[i]; float mm = -3.0e38f;
                    if (dir == 0) { for (int j = 0; j <= i; ++j) mm = fmaxf(mm, bi - bs[j] + igs[j]); } else { for (int j = i; j < 128; ++j) mm = fmaxf(mm, bi - bs[j] + igs[j]); }
                    const float lin = bi + mprev, mi = fmaxf(mm, lin); mis[i] = mi; wis[i] = expf(lin - mi);
                    float qn = 0.f; if (has) for (int k = 0; k < 128; ++k) qn += bf2f(Q_l[i * QLD + k]) * MN[si * 128 + k];
                    qns[i] = qn; }
                __syncthreads();
                { const int j = F.tid & 127, g4 = F.tid >> 7;
                  for (int i = g4 * 32; i < g4 * 32 + 32; ++i) { const bool ok = dir == 0 ? j <= i : j >= i; float s = 0.f;
                      if (ok) { for (int d = 0; d < 128; ++d) s += bf2f(Q_l[i * QLD + d]) * bf2f(K_l[j * QLD + d]); s *= expf(bs[i] - bs[j] + igs[j] - mis[i]); }
                      SM[i * 129 + j] = s; } }
                __syncthreads();
                if (F.tid < 128) { const int i = F.tid; float den = 0.f; for (int j = 0; j < 128; ++j) den += SM[i * 129 + j]; den += wis[i] * qns[i];
                    rds[i] = 1.f / fmaxf(fabsf(den), expf(-mis[i])); }
                __syncthreads();
                const bf16* Cp = MC + si * 16384 + v * 128;
#pragma unroll
                for (int rg = 0; rg < 2; ++rg) { const int r0 = ig * 32 + rg * 16; float num[16];
#pragma unroll
                    for (int ii = 0; ii < 16; ++ii) num[ii] = 0.f;
                    if (has) { for (int k = 0; k < 128; ++k) { const float c = bf2f(Cp[k]);
#pragma unroll
                            for (int ii = 0; ii < 16; ++ii) num[ii] += bf2f(Q_l[(r0 + ii) * QLD + k]) * c; } }
#pragma unroll
                    for (int ii = 0; ii < 16; ++ii) num[ii] *= wis[r0 + ii];
                    for (int j = 0; j < 128; ++j) { const float vv = bf2f(PA[(size_t)(row0 + j) * PA_LD + C_MV + h * 128 + v]);
#pragma unroll
                        for (int ii = 0; ii < 16; ++ii) num[ii] += bf2f((bf16)f2bf(SM[(r0 + ii) * 129 + j])) * vv; }
#pragma unroll
                    for (int ii = 0; ii < 16; ++ii) hacc[rg * 16 + ii] += num[ii] * rds[r0 + ii]; }
            }
            __syncthreads();
#pragma unroll
            for (int ii = 0; ii < 32; ++ii) { const int i = ig * 32 + ii; const float hm = hacc[ii] * bf2f(PA[(size_t)(row0 + i) * PA_LD + C_MO + h * 128 + v]);
                park[i * 128 + v] = hm; const float s1 = wave_sum(hm), s2 = wave_sum(hm * hm);
                if (F.lane == 0) { red[(i * 2 + (F.wave & 1)) * 2] = s1; red[(i * 2 + (F.wave & 1)) * 2 + 1] = s2; } }
            __syncthreads();
            const float gn = a.in[I_MGN][h * 128 + v];
            for (int i = ig * 32; i < ig * 32 + 32; ++i) { const float s1 = red[(i * 2) * 2] + red[(i * 2 + 1) * 2], s2 = red[(i * 2) * 2 + 1] + red[(i * 2 + 1) * 2 + 1];
                const float mu = s1 * (1.f / 128.f), var = fmaxf(s2 * (1.f / 128.f) - mu * mu, 0.f);
                PA[(size_t)(row0 + i) * PA_LD + C_MV + h * 128 + v] = (bf16)f2bf((park[i * 128 + v] - mu) * (1.f / sqrtf(var + EPS_GN)) * gn); }
        }
    }
}

typedef short bf16x8 __attribute__((ext_vector_type(8)));
typedef short s16x4 __attribute__((ext_vector_type(4)));
#define MFMA16(a, b, c) __builtin_amdgcn_mfma_f32_16x16x32_bf16(a, b, c, 0, 0, 0)
constexpr float KSCALE = 0.08838834764831845f;
constexpr int LQ = 136, LV = 264;

__device__ __forceinline__ bf16x8 frag_row(const LAS bf16* T, int LD, int r0, int k0, int lane) { return *(const LAS bf16x8*)(T + (r0 + (lane & 15)) * LD + k0 + 8 * (lane >> 4)); }
__device__ __forceinline__ bf16x8 frag_row_g(const bf16* T, int LD, int r0, int k0, int lane) { return *(const bf16x8*)(T + (size_t)(r0 + (lane & 15)) * LD + k0 + 8 * (lane >> 4)); }
__device__ __forceinline__ bf16x8 frag_tr(const LAS bf16* T, int LD, int k0, int n0, int lane) {
    const LAS bf16* p = T + (k0 + 8 * (lane >> 4) + ((lane & 15) >> 2)) * LD + n0 + 4 * (lane & 3);
    const s16x4 lo = __builtin_amdgcn_ds_read_tr16_b64_v4i16((LAS s16x4*)p), hi = __builtin_amdgcn_ds_read_tr16_b64_v4i16((LAS s16x4*)(p + 4 * LD));
    return (bf16x8){lo[0], lo[1], lo[2], lo[3], hi[0], hi[1], hi[2], hi[3]};
}
__device__ __forceinline__ void unpack8(const v4u v, float (&f)[8]) { f[0] = bflo(v.x); f[1] = bfhi(v.x); f[2] = bflo(v.y); f[3] = bfhi(v.y); f[4] = bflo(v.z); f[5] = bfhi(v.z); f[6] = bflo(v.w); f[7] = bfhi(v.w); }
__device__ __forceinline__ v4u pack8(const float (&f)[8]) { v4u w; w.x = pk2(f[0], f[1]); w.y = pk2(f[2], f[3]); w.z = pk2(f[4], f[5]); w.w = pk2(f[6], f[7]); return w; }
template <int W, int LD> __device__ __forceinline__ void stage_tile(LAS bf16* T, const bf16* src, int ld_src, int tid) {
    constexpr int CPR = W / 8;
    for (int c = tid; c < 128 * CPR; c += 512) { const int r = c / CPR, cc = c % CPR; *(LAS v4u*)(T + r * LD + cc * 8) = *(const v4u*)(src + (size_t)r * ld_src + cc * 8); }
}
struct ConvW { float w0[8], w1[8], w2[8], b[8]; };
__device__ __forceinline__ void conv_load(ConvW& c, const float* cw, const float* cb, int ch) {
#pragma unroll
    for (int i = 0; i < 8; ++i) { c.w0[i] = cw[ch + i]; c.w1[i] = cw[1024 + ch + i]; c.w2[i] = cw[2048 + ch + i]; c.b[i] = cb[ch + i]; }
}
__device__ __forceinline__ void conv_chunk(const ConvW& c, const bf16* p, bool first, bool last, float scale, float (&y)[8]) {
    const v4u z = {0u, 0u, 0u, 0u}; const v4u x0 = *(const v4u*)p, xm = first ? z : *(const v4u*)(p - PA_LD), xp = last ? z : *(const v4u*)(p + PA_LD);
    float f0[8], fm[8], fp[8]; unpack8(x0, f0); unpack8(xm, fm); unpack8(xp, fp);
#pragma unroll
    for (int i = 0; i < 8; ++i) y[i] = silu_f(c.b[i] + c.w0[i] * fm[i] + c.w1[i] * f0[i] + c.w2[i] * fp[i]) * scale;
}

__device__ __forceinline__ void p6_mfma(const Args& a, int tid_in, int bid, int G, LAS unsigned char* L) {
    const bf16* PA = (const bf16*)(a.ws + WS_PA); bf16* RS = (bf16*)(a.ws + WS_RS); bf16* MC = (bf16*)(a.ws + WS_MC);
    float* MN = (float*)(a.ws + WS_MN); float* MS = (float*)(a.ws + WS_MS);
    const float* IG = (const float*)(a.ws + WS_IG); const float* LF = (const float*)(a.ws + WS_LF);
    for (int it = bid; it < 2 * NCHUNK * 4; it += G) {
        int tid = tid_in; asm volatile("" : "+v"(tid));
        const int lane = tid & 63, wave = __builtin_amdgcn_readfirstlane(tid >> 6);
        const int branch = it / (NCHUNK * 4), gc = (it % (NCHUNK * 4)) >> 2, h = it & 3, row0 = gc * CH; int n, N; chunk_info(gc, n, N);
        __syncthreads();
        if (branch == 0) {
            LAS bf16* V_l = (LAS bf16*)L; LAS bf16* Kf = (LAS bf16*)(L + 67584); LAS bf16* Kb = (LAS bf16*)(L + 67584 + 34816);
            const float lg0 = logsigmoid_f(a.in[I_DECAY][h]), lg1 = logsigmoid_f(a.in[I_DECAY][4 + h]);
            stage_tile<256, LV>(V_l, PA + (size_t)row0 * PA_LD + C_RV + h * 256, PA_LD, tid);
            for (int c = tid; c < 128 * 16; c += 512) { const int j = c >> 4, cc = c & 15; float f[8], g[8];
                unpack8(*(const v4u*)(PA + (size_t)(row0 + j) * PA_LD + C_RK + h * 128 + cc * 8), f);
                const float wf = __expf(lg0 * (float)(127 - j)), wb = __expf(lg1 * (float)j);
#pragma unroll
                for (int i = 0; i < 8; ++i) { g[i] = f[i] * wb; f[i] *= wf; }
                *(LAS v4u*)(Kf + j * LQ + cc * 8) = pack8(f); *(LAS v4u*)(Kb + j * LQ + cc * 8) = pack8(g); }
            __syncthreads();
#pragma unroll 1
            for (int dir = 0; dir < 2; ++dir) { const LAS bf16* Kd = dir ? Kb : Kf; pg8::f32x4 acc[2][8];
#pragma unroll
                for (int m = 0; m < 2; ++m)
#pragma unroll
                    for (int nn = 0; nn < 8; ++nn) acc[m][nn] = (pg8::f32x4){0.f, 0.f, 0.f, 0.f};
#pragma unroll 1
                for (int k0 = 0; k0 < 128; k0 += 32) { bf16x8 af[2];
#pragma unroll
                    for (int m = 0; m < 2; ++m) af[m] = frag_tr(V_l, LV, k0, wave * 32 + m * 16, lane);
#pragma unroll
                    for (int nn = 0; nn < 8; ++nn) { const bf16x8 bfr = frag_tr(Kd, LQ, k0, nn * 16, lane);
#pragma unroll
                        for (int m = 0; m < 2; ++m) acc[m][nn] = MFMA16(bfr, af[m], acc[m][nn]); } }
                bf16* out = RS + st_idx(gc, h, dir) * 32768;
#pragma unroll
                for (int m = 0; m < 2; ++m)
#pragma unroll
                    for (int nn = 0; nn < 8; ++nn) { v2u w; w.x = cvt_pk_bf16(acc[m][nn][0], acc[m][nn][1]); w.y = cvt_pk_bf16(acc[m][nn][2], acc[m][nn][3]);
                        *(v2u*)(out + (wave * 32 + m * 16 + (lane & 15)) * 128 + nn * 16 + 4 * (lane >> 4)) = w; }
            }
        } else {
            LAS bf16* V_l = (LAS bf16*)L; LAS bf16* Kf = (LAS bf16*)(L + 34816); LAS bf16* Kb = (LAS bf16*)(L + 2 * 34816);
            LAS float* sml = (LAS float*)(L + 3 * 34816); LAS float* lfs = sml; LAS float* igs = sml + 256; LAS float* bs = sml + 512; LAS float* ws_ = sml + 768;
            stage_tile<128, LQ>(V_l, PA + (size_t)row0 * PA_LD + C_MV + h * 128, PA_LD, tid);
            if (tid < 256) { const int dir = tid >> 7, j = tid & 127; lfs[tid] = LF[(size_t)(row0 + j) * 8 + dir * 4 + h]; igs[tid] = IG[(size_t)(row0 + j) * 8 + dir * 4 + h]; }
            __syncthreads();
            if (tid < 256) { const int dir = tid >> 7, j = tid & 127; float b = 0.f;
                if (dir == 0) { for (int t = 0; t <= j; ++t) b += lfs[t]; } else { for (int t = 127; t >= j; --t) b += lfs[128 + t]; }
                bs[tid] = b; }
            __syncthreads();
            if (tid < 256) { const int dir = tid >> 7, j = tid & 127; const float blast = dir ? bs[128] : bs[127]; float ml = -3.0e38f;
                for (int t = 0; t < 128; ++t) ml = fmaxf(ml, blast - bs[dir * 128 + t] + igs[dir * 128 + t]);
                ws_[tid] = expf(blast - bs[tid] + igs[tid] - ml);
                if (j == 0) { MS[st_idx(gc, h, dir) * 4 + 0] = ml; MS[st_idx(gc, h, dir) * 4 + 1] = blast; } }
            __syncthreads();
            { ConvW cwv; const int cc = tid & 15; conv_load(cwv, a.in[I_CONVW], a.in[I_CONVB], 512 + h * 128 + cc * 8);
              for (int c = tid; c < 128 * 16; c += 512) { const int j = c >> 4; float f[8], g[8];
                  conv_chunk(cwv, PA + (size_t)(row0 + j) * PA_LD + C_MK + h * 128 + cc * 8, n == 0 && j == 0, n == N - 1 && j == 127, KSCALE, f);
                  const float wf = ws_[j], wb = ws_[128 + j];
#pragma unroll
                  for (int i = 0; i < 8; ++i) { const float kq = bf2f((bf16)f2bf(f[i])); g[i] = kq * wb; f[i] = kq * wf; }
                  *(LAS v4u*)(Kf + j * LQ + cc * 8) = pack8(f); *(LAS v4u*)(Kb + j * LQ + cc * 8) = pack8(g); } }
            __syncthreads();
            if (tid < 256) { const int dir = tid >> 7, k = tid & 127; const LAS bf16* Kd = dir ? Kb : Kf; float s = 0.f;
                for (int j = 0; j < 128; ++j) s += bf2f(Kd[j * LQ + k]);
                MN[st_idx(gc, h, dir) * 128 + k] = s; }
#pragma unroll 1
            for (int dir = 0; dir < 2; ++dir) { const LAS bf16* Kd = dir ? Kb : Kf; pg8::f32x4 acc[8];
#pragma unroll
                for (int nn = 0; nn < 8; ++nn) acc[nn] = (pg8::f32x4){0.f, 0.f, 0.f, 0.f};
#pragma unroll 1
                for (int k0 = 0; k0 < 128; k0 += 32) { const bf16x8 af = frag_tr(V_l, LQ, k0, wave * 16, lane);
#pragma unroll
                    for (int nn = 0; nn < 8; ++nn) { const bf16x8 bfr = frag_tr(Kd, LQ, k0, nn * 16, lane); acc[nn] = MFMA16(bfr, af, acc[nn]); } }
                bf16* out = MC + st_idx(gc, h, dir) * 16384;
#pragma unroll
                for (int nn = 0; nn < 8; ++nn) { v2u w; w.x = cvt_pk_bf16(acc[nn][0], acc[nn][1]); w.y = cvt_pk_bf16(acc[nn][2], acc[nn][3]);
                    *(v2u*)(out + (wave * 16 + (lane & 15)) * 128 + nn * 16 + 4 * (lane >> 4)) = w; }
            }
        }
    }
}

__device__ __forceinline__ void p8_mfma(const Args& a, int tid_in, int bid, int G, LAS unsigned char* L) {
    bf16* PA = (bf16*)(a.ws + WS_PA); const bf16* RS = (const bf16*)(a.ws + WS_RS); const bf16* MC = (const bf16*)(a.ws + WS_MC);
    const float* MN = (const float*)(a.ws + WS_MN); const float* MS = (const float*)(a.ws + WS_MS);
    const float* IG = (const float*)(a.ws + WS_IG); const float* LF = (const float*)(a.ws + WS_LF);
    LAS bf16* Q_l = (LAS bf16*)L; LAS bf16* K_l = (LAS bf16*)(L + 34816); LAS bf16* P_l = K_l; LAS bf16* V_l = (LAS bf16*)(L + 2 * 34816);
    for (int it = bid; it < 2 * NCHUNK * 4; it += G) {
        int tid = tid_in; asm volatile("" : "+v"(tid));
        const int lane = tid & 63, wave = __builtin_amdgcn_readfirstlane(tid >> 6), fr = lane & 15, fq = lane >> 4;
        const int branch = it / (NCHUNK * 4), gc = (it % (NCHUNK * 4)) >> 2, h = it & 3, row0 = gc * CH; int n, N; chunk_info(gc, n, N);
        const bool lat = gc >= 32;
        __syncthreads();
        if (branch == 0) {
            LAS float* red = (LAS float*)(L + 2 * 34816 + 67584);
            const float lg0 = logsigmoid_f(a.in[I_DECAY][h]), lg1 = logsigmoid_f(a.in[I_DECAY][4 + h]);
            stage_tile<128, LQ>(Q_l, PA + (size_t)row0 * PA_LD + C_RQ + h * 128, PA_LD, tid);
            stage_tile<128, LQ>(K_l, PA + (size_t)row0 * PA_LD + C_RK + h * 128, PA_LD, tid);
            stage_tile<256, LV>(V_l, PA + (size_t)row0 * PA_LD + C_RV + h * 256, PA_LD, tid);
            __syncthreads();
            {
                pg8::f32x4 sc[8];
#pragma unroll
                for (int m = 0; m < 8; ++m) sc[m] = (pg8::f32x4){0.f, 0.f, 0.f, 0.f};
#pragma unroll 1
                for (int k0 = 0; k0 < 128; k0 += 32) { const bf16x8 bfr = frag_row(K_l, LQ, wave * 16, k0, lane);
#pragma unroll
                    for (int m = 0; m < 8; ++m) sc[m] = MFMA16(bfr, frag_row(Q_l, LQ, m * 16, k0, lane), sc[m]); }
                __syncthreads();
#pragma unroll
                for (int m = 0; m < 8; ++m) { const int i = m * 16 + fr; float p[4];
#pragma unroll
                    for (int r = 0; r < 4; ++r) { const int j = wave * 16 + 4 * fq + r; const float dm = i > j ? __expf(lg0 * (float)(i - j)) : (i < j ? __expf(lg1 * (float)(j - i)) : 2.f); p[r] = sc[m][r] * dm; }
                    v2u w; w.x = cvt_pk_bf16(p[0], p[1]); w.y = cvt_pk_bf16(p[2], p[3]); *(LAS v2u*)(P_l + i * LQ + wave * 16 + 4 * fq) = w; }
            }
            __syncthreads();
            pg8::f32x4 accR[8][2];
#pragma unroll
            for (int m = 0; m < 8; ++m) { accR[m][0] = (pg8::f32x4){0.f, 0.f, 0.f, 0.f}; accR[m][1] = (pg8::f32x4){0.f, 0.f, 0.f, 0.f}; }
            {   const bool hasf = lat || n > 0, hasb = lat || n < N - 1;
#pragma unroll 1
                for (int dir = 0; dir < 2; ++dir) {
                    if (!(dir ? hasb : hasf)) continue;
                    const bf16* S = RS + st_idx(gc, h, dir) * 32768;
#pragma unroll 1
                    for (int k0 = 0; k0 < 128; k0 += 32) { const bf16x8 b0 = frag_row_g(S, 128, wave * 32, k0, lane), b1 = frag_row_g(S, 128, wave * 32 + 16, k0, lane);
#pragma unroll
                        for (int m = 0; m < 8; ++m) { const bf16x8 af = frag_row(Q_l, LQ, m * 16, k0, lane); accR[m][0] = MFMA16(b0, af, accR[m][0]); accR[m][1] = MFMA16(b1, af, accR[m][1]); } }
#pragma unroll
                    for (int m = 0; m < 8; ++m) { const float i = (float)(m * 16 + fr); const float ef = lg0 * (i + 1.f), eb = lg1 * (128.f - i);
                        const float wq = dir ? __expf(eb) : (hasb ? __expf(ef - eb) : __expf(ef));
                        accR[m][0] *= wq; accR[m][1] *= wq; }
                }
            }
#pragma unroll 1
            for (int k0 = 0; k0 < 128; k0 += 32) { const bf16x8 b0 = frag_tr(V_l, LV, k0, wave * 32, lane), b1 = frag_tr(V_l, LV, k0, wave * 32 + 16, lane);
#pragma unroll
                for (int m = 0; m < 8; ++m) { const bf16x8 af = frag_row(P_l, LQ, m * 16, k0, lane); accR[m][0] = MFMA16(b0, af, accR[m][0]); accR[m][1] = MFMA16(b1, af, accR[m][1]); } }
#pragma unroll
            for (int m = 0; m < 8; ++m) { float s1 = 0.f, s2 = 0.f;
#pragma unroll
                for (int nn = 0; nn < 2; ++nn)
#pragma unroll
                    for (int r = 0; r < 4; ++r) { const float x = accR[m][nn][r]; s1 += x; s2 += x * x; }
                s1 += __shfl_xor(s1, 16); s1 += __shfl_xor(s1, 32); s2 += __shfl_xor(s2, 16); s2 += __shfl_xor(s2, 32);
                if (fq == 0) { red[((m * 16 + fr) * 8 + wave) * 2] = s1; red[((m * 16 + fr) * 8 + wave) * 2 + 1] = s2; } }
            __syncthreads();
            pg8::f32x4 gnv[2];
#pragma unroll
            for (int nn = 0; nn < 2; ++nn) gnv[nn] = *(const pg8::f32x4*)(a.in[I_RETGN] + h * 256 + wave * 32 + nn * 16 + 4 * fq);
#pragma unroll
            for (int m = 0; m < 8; ++m) { const int i = m * 16 + fr; float s1 = 0.f, s2 = 0.f;
#pragma unroll
                for (int w = 0; w < 8; ++w) { s1 += red[(i * 8 + w) * 2]; s2 += red[(i * 8 + w) * 2 + 1]; }
                const float mu = s1 * (1.f / 256.f), rstd = 1.f / sqrtf(fmaxf(s2 * (1.f / 256.f) - mu * mu, 0.f) + EPS_GN);
#pragma unroll
                for (int nn = 0; nn < 2; ++nn) { const pg8::f32x4 y = (accR[m][nn] - mu) * rstd * gnv[nn]; v2u w; w.x = cvt_pk_bf16(y[0], y[1]); w.y = cvt_pk_bf16(y[2], y[3]);
                    *(v2u*)(PA + (size_t)(row0 + i) * PA_LD + C_RV + h * 256 + wave * 32 + nn * 16 + 4 * fq) = w; } }
        } else {
            LAS bf16* Vm = (LAS bf16*)(L + 2 * 34816);
            LAS float* sml = (LAS float*)(L + 3 * 34816);
            LAS float* lfs = sml; LAS float* igs = sml + 256; LAS float* bs = sml + 512; LAS float* mis = sml + 768; LAS float* wis = sml + 1024; LAS float* qns = sml + 1280; LAS float* rds = sml + 1536;
            LAS float* red = sml + 1792;
            const size_t si0 = st_idx(gc, h, 0), si1 = si0 + 1;
            {   ConvW cq, ck; const int cc = tid & 15; conv_load(cq, a.in[I_CONVW], a.in[I_CONVB], h * 128 + cc * 8); conv_load(ck, a.in[I_CONVW], a.in[I_CONVB], 512 + h * 128 + cc * 8);
                for (int c = tid; c < 128 * 16; c += 512) { const int j = c >> 4; const bool fi = n == 0 && j == 0, la = n == N - 1 && j == 127; float f[8];
                    conv_chunk(cq, PA + (size_t)(row0 + j) * PA_LD + C_MQ + h * 128 + cc * 8, fi, la, 1.f, f); *(LAS v4u*)(Q_l + j * LQ + cc * 8) = pack8(f);
                    conv_chunk(ck, PA + (size_t)(row0 + j) * PA_LD + C_MK + h * 128 + cc * 8, fi, la, KSCALE, f); *(LAS v4u*)(K_l + j * LQ + cc * 8) = pack8(f); } }
            stage_tile<128, LQ>(Vm, PA + (size_t)row0 * PA_LD + C_MV + h * 128, PA_LD, tid);
            if (tid < 256) { const int dir = tid >> 7, j = tid & 127; lfs[tid] = LF[(size_t)(row0 + j) * 8 + dir * 4 + h]; igs[tid] = IG[(size_t)(row0 + j) * 8 + dir * 4 + h]; }
            __syncthreads();
            if (tid < 256) { const int dir = tid >> 7, i = tid & 127; float b = 0.f;
                if (dir == 0) { for (int t = 0; t <= i; ++t) b += lfs[t]; } else { for (int t = 127; t >= i; --t) b += lfs[128 + t]; }
                bs[tid] = b;
                float qn = 0.f; const float* np = MN + (si0 + dir) * 128; for (int k = 0; k < 128; ++k) qn += bf2f(Q_l[i * LQ + k]) * np[k];
                qns[tid] = qn; }
            __syncthreads();
            if (tid < 256) { const int dir = tid >> 7, i = tid & 127; const float bi = bs[tid]; float pm = -3.0e38f;
                if (dir == 0) { for (int j = 0; j <= i; ++j) pm = fmaxf(pm, igs[j] - bs[j]); } else { for (int j = i; j < 128; ++j) pm = fmaxf(pm, igs[128 + j] - bs[128 + j]); }
                const float mprev = MS[(si0 + dir) * 4 + 2]; const float lin = bi + mprev, mi = fmaxf(bi + pm, lin); mis[tid] = mi; wis[tid] = expf(lin - mi); }
            __syncthreads();
            {
                pg8::f32x4 sc[8];
#pragma unroll
                for (int m = 0; m < 8; ++m) sc[m] = (pg8::f32x4){0.f, 0.f, 0.f, 0.f};
#pragma unroll 1
                for (int k0 = 0; k0 < 128; k0 += 32) { const bf16x8 bfr = frag_row(K_l, LQ, wave * 16, k0, lane);
#pragma unroll
                    for (int m = 0; m < 8; ++m) sc[m] = MFMA16(bfr, frag_row(Q_l, LQ, m * 16, k0, lane), sc[m]); }
                pg8::f32x4 s0[8], s1[8];
#pragma unroll
                for (int m = 0; m < 8; ++m) { const int i = m * 16 + fr; const float e0 = bs[i] - mis[i], e1 = bs[128 + i] - mis[128 + i]; float r0 = 0.f, r1 = 0.f;
#pragma unroll
                    for (int r = 0; r < 4; ++r) { const int j = wave * 16 + 4 * fq + r;
                        s0[m][r] = j <= i ? sc[m][r] * __expf(e0 - bs[j] + igs[j]) : 0.f; s1[m][r] = j >= i ? sc[m][r] * __expf(e1 - bs[128 + j] + igs[128 + j]) : 0.f;
                        r0 += s0[m][r]; r1 += s1[m][r]; }
                    r0 += __shfl_xor(r0, 16); r0 += __shfl_xor(r0, 32); r1 += __shfl_xor(r1, 16); r1 += __shfl_xor(r1, 32);
                    if (fq == 0) { red[i * 8 + wave] = r0; red[(128 + i) * 8 + wave] = r1; } }
                __syncthreads();
                if (tid < 256) { float den = 0.f;
#pragma unroll
                    for (int w = 0; w < 8; ++w) den += red[tid * 8 + w];
                    den += wis[tid] * qns[tid]; rds[tid] = 1.f / fmaxf(fabsf(den), expf(-mis[tid])); }
                __syncthreads();
#pragma unroll
                for (int m = 0; m < 8; ++m) { const int i = m * 16 + fr; const float d0 = rds[i], d1 = rds[128 + i];
                    const pg8::f32x4 p = s0[m] * d0 + s1[m] * d1; v2u w; w.x = cvt_pk_bf16(p[0], p[1]); w.y = cvt_pk_bf16(p[2], p[3]); *(LAS v2u*)(P_l + i * LQ + wave * 16 + 4 * fq) = w; }
            }
            __syncthreads();
            pg8::f32x4 accH[8];
#pragma unroll
            for (int m = 0; m < 8; ++m) accH[m] = (pg8::f32x4){0.f, 0.f, 0.f, 0.f};
#pragma unroll 1
            for (int dir = 0; dir < 2; ++dir) {
                const bool has = lat || (dir ? n < N - 1 : n > 0); if (!has) continue;
                const bf16* Cp = MC + (si0 + dir) * 16384; pg8::f32x4 accX[8];
#pragma unroll
                for (int m = 0; m < 8; ++m) accX[m] = (pg8::f32x4){0.f, 0.f, 0.f, 0.f};
#pragma unroll 1
                for (int k0 = 0; k0 < 128; k0 += 32) { const bf16x8 bfr = frag_row_g(Cp, 128, wave * 16, k0, lane);
#pragma unroll
                    for (int m = 0; m < 8; ++m) accX[m] = MFMA16(bfr, frag_row(Q_l, LQ, m * 16, k0, lane), accX[m]); }
#pragma unroll
                for (int m = 0; m < 8; ++m) { const int i = dir * 128 + m * 16 + fr; accH[m] += accX[m] * (wis[i] * rds[i]); }
            }
#pragma unroll 1
            for (int k0 = 0; k0 < 128; k0 += 32) { const bf16x8 bfr = frag_tr(Vm, LQ, k0, wave * 16, lane);
#pragma unroll
                for (int m = 0; m < 8; ++m) accH[m] = MFMA16(bfr, frag_row(P_l, LQ, m * 16, k0, lane), accH[m]); }
            __syncthreads();
#pragma unroll
            for (int m = 0; m < 8; ++m) { const int i = m * 16 + fr; const v2u g = *(const v2u*)(PA + (size_t)(row0 + i) * PA_LD + C_MO + h * 128 + wave * 16 + 4 * fq);
                accH[m][0] *= bflo(g.x); accH[m][1] *= bfhi(g.x); accH[m][2] *= bflo(g.y); accH[m][3] *= bfhi(g.y);
                float s1 = (accH[m][0] + accH[m][1]) + (accH[m][2] + accH[m][3]), s2 = (accH[m][0] * accH[m][0] + accH[m][1] * accH[m][1]) + (accH[m][2] * accH[m][2] + accH[m][3] * accH[m][3]);
                s1 += __shfl_xor(s1, 16); s1 += __shfl_xor(s1, 32); s2 += __shfl_xor(s2, 16); s2 += __shfl_xor(s2, 32);
                if (fq == 0) { red[(i * 8 + wave) * 2] = s1; red[(i * 8 + wave) * 2 + 1] = s2; } }
            __syncthreads();
            const pg8::f32x4 gnv = *(const pg8::f32x4*)(a.in[I_MGN] + h * 128 + wave * 16 + 4 * fq);
#pragma unroll
            for (int m = 0; m < 8; ++m) { const int i = m * 16 + fr; float s1 = 0.f, s2 = 0.f;
#pragma unroll
                for (int w = 0; w < 8; ++w) { s1 += red[(i * 8 + w) * 2]; s2 += red[(i * 8 + w) * 2 + 1]; }
                const float mu = s1 * (1.f / 128.f), rstd = 1.f / sqrtf(fmaxf(s2 * (1.f / 128.f) - mu * mu, 0.f) + EPS_GN);
                const pg8::f32x4 y = (accH[m] - mu) * rstd * gnv; v2u w; w.x = cvt_pk_bf16(y[0], y[1]); w.y = cvt_pk_bf16(y[2], y[3]);
                *(v2u*)(PA + (size_t)(row0 + i) * PA_LD + C_MV + h * 128 + wave * 16 + 4 * fq) = w; }
        }
    }
}

constexpr int NPHASE = 16;
#ifndef MK_PER_PHASE
#define MK_PER_PHASE 0
#endif
#ifndef MIX6
#define MIX6 1
#endif
#ifndef MIX7
#define MIX7 1
#endif
#ifndef MIX8
#define MIX8 1
#endif
#define MIXER_MFMA (MIX6 && MIX7 && MIX8)
#define GEMM_PHASE(EPI, g, S, E) pg8::gemm_phase<EPI, pg8::StaticOrder, true, true>((PG8_LAS unsigned char*)lds, g, S, E)

__global__ void __launch_bounds__(512, 2) fwd_kernel(Args a) {
    extern __shared__ __attribute__((aligned(16))) unsigned char lds[];
    Frame F; F.lds = lds; F.tid = threadIdx.x; F.lane = F.tid & 63; F.wave = __builtin_amdgcn_readfirstlane(F.tid >> 6);
    F.G = gridDim.x; F.bid = blockIdx.x; F.gw = F.bid * 8 + F.wave; F.ngw = F.G * 8;
    volatile LAS unsigned* MISC = (volatile LAS unsigned*)((LAS unsigned char*)lds + MISC_OFF);
    if (F.tid < 64) MISC[F.tid] = 0u;
    __syncthreads();
    unsigned char* ws = a.ws;
    XcdBarrier bar; bar.bar = (unsigned*)(ws + WS_CTL) + CW_BAR; bar.x = 0; bar.st = nullptr;
    const bool multi = (a.ph_hi - a.ph_lo) > 1;
    if (multi) bar = xcd_barrier_post((unsigned*)(ws + WS_CTL) + CW_BAR, MISC + 8);
    const int lo = a.ph_lo, hi = a.ph_hi;
#define IN(k) (lo <= (k) && (k) < hi)
#define SEAM(k) do { if (IN(k) && IN((k) + 1)) xcd_barrier(bar); } while (0)
    const float* mod = (const float*)(ws + WS_MOD);
    bf16* U = (bf16*)(ws + WS_U); bf16* H = (bf16*)(ws + WS_H); bf16* PA = (bf16*)(ws + WS_PA); bf16* BG = (bf16*)(ws + WS_BG); bf16* T1 = (bf16*)(ws + WS_T1);
    float* X = a.out + OUT_Y;

    if (IN(0)) { p0_prologue(a, F); } SEAM(0);
    if (IN(1)) { norm_phase<false>(a, F, a.in[I_XP], a.in[I_XS], a.in[I_NF1], 0 * D, 1 * D); } SEAM(1);
    if (IN(2)) { pg8::Gemm g{U, (const bf16*)(ws + WS_W13A), MROWS, 2 * FF, D, D}; pg8::StaticOrder S; S.init(MROWS, 2 * FF, F.G, F.bid); EpiSwiGLU E{H}; GEMM_PHASE(EpiSwiGLU, g, S, E); } SEAM(2);
    if (IN(3)) { pg8::Gemm g{H, (const bf16*)(ws + WS_W2A), MROWS, D, FF, FF}; pg8::StaticOrder S; S.init(MROWS, D, F.G, F.bid); EpiResid E{a.in[I_XP], a.in[I_XS], X, mod + 2 * D, 0.5f}; GEMM_PHASE(EpiResid, g, S, E); } SEAM(3);
    if (IN(4)) { norm_phase<true>(a, F, X, X + (size_t)NCTX * D, a.in[I_NMIX], 3 * D, 4 * D); } SEAM(4);
    if (IN(5)) { pg8::Gemm g{U, (const bf16*)(ws + WS_WIN), MROWS, 4096, D, D}; pg8::StaticOrder S; S.init(MROWS, 4096, F.G, F.bid); EpiProjA E{PA, (const float2*)(ws + WS_ROPE)}; GEMM_PHASE(EpiProjA, g, S, E); } SEAM(5);
#if MIX6
    if (IN(6)) { p6_mfma(a, F.tid, F.bid, F.G, (LAS unsigned char*)lds); }
#endif
    SEAM(6);
#if MIX7
    if (IN(7)) { p7_scalar(a, F); }
#endif
    SEAM(7);
#if MIX8
    if (IN(8)) { p8_mfma(a, F.tid, F.bid, F.G, (LAS unsigned char*)lds); }
#endif
    SEAM(8);
    if (IN(9)) { pg8::Gemm g{U, (const bf16*)(ws + WS_WIN) + (size_t)4096 * D, MROWS, 3072, D, D}; pg8::StaticOrder S; S.init(MROWS, 3072, F.G, F.bid); EpiProjB E{PA, BG}; GEMM_PHASE(EpiProjB, g, S, E); } SEAM(9);
    if (IN(10)) {
        { pg8::Gemm g{PA + C_RV, (const bf16*)(ws + WS_WR), MROWS, D, D, PA_LD}; pg8::StaticOrder S; S.init(MROWS, D, F.G, F.bid); EpiMerge<false> E{BG, T1, U}; GEMM_PHASE(EpiMerge<false>, g, S, E); }
        { pg8::Gemm g{PA + C_MV, (const bf16*)(ws + WS_WM), MROWS, D, 512, PA_LD}; pg8::StaticOrder S; S.init(MROWS, D, F.G, F.bid); EpiMerge<true> E{BG, T1, U}; GEMM_PHASE(EpiMerge<true>, g, S, E); }
    } SEAM(10);
    if (IN(11)) { pg8::Gemm g{U, (const bf16*)(ws + WS_WO), MROWS, D, D, D}; pg8::StaticOrder S; S.init(MROWS, D, F.G, F.bid); EpiResid E{X, X + (size_t)NCTX * D, X, mod + 5 * D, 1.0f}; GEMM_PHASE(EpiResid, g, S, E); } SEAM(11);
    if (IN(12)) { norm_phase<false>(a, F, X, X + (size_t)NCTX * D, a.in[I_NF2], 6 * D, 7 * D); } SEAM(12);
    if (IN(13)) { pg8::Gemm g{U, (const bf16*)(ws + WS_W13B), MROWS, 2 * FF, D, D}; pg8::StaticOrder S; S.init(MROWS, 2 * FF, F.G, F.bid); EpiSwiGLU E{H}; GEMM_PHASE(EpiSwiGLU, g, S, E); } SEAM(13);
    if (IN(14)) { pg8::Gemm g{H, (const bf16*)(ws + WS_W2B), MROWS, D, FF, FF}; pg8::StaticOrder S; S.init(MROWS, D, F.G, F.bid); EpiResid E{X, X + (size_t)NCTX * D, X, mod + 8 * D, 0.5f}; GEMM_PHASE(EpiResid, g, S, E); } SEAM(14);
    if (IN(15)) { final_norm_phase(a, F); }
#undef IN
#undef SEAM
}

#if !MIXER_MFMA
template <int WHICH> __global__ void __launch_bounds__(512, 2) mixer_dbg_kernel(Args a) {
    extern __shared__ __attribute__((aligned(16))) unsigned char lds[];
    Frame F; F.lds = lds; F.tid = threadIdx.x; F.lane = F.tid & 63; F.wave = __builtin_amdgcn_readfirstlane(F.tid >> 6);
    F.G = gridDim.x; F.bid = blockIdx.x; F.gw = F.bid * 8 + F.wave; F.ngw = F.G * 8;
    if (WHICH == 0) p6_scalar(a, F);
    if (WHICH == 1) p7_scalar(a, F);
    if (WHICH == 2) p8_scalar<0>(a, F);
    if (WHICH == 3) p8_scalar<1>(a, F);
}
#endif
extern "C" void kernel_launch(void* const* d_in, const int* in_sizes, int n_in, void* d_out, int out_size, void* d_ws, size_t ws_size, hipStream_t stream) {
    static int grid = 0;
    if (grid == 0) {
        if (n_in != 31 || (size_t)out_size != OUT_END || ws_size < WS_END) { fprintf(stderr, "kernel_launch: unexpected shapes: n_in %d out %d ws %zu\n", n_in, out_size, ws_size); grid = -1; return; }
        int dev = 0, cus = 0, per_cu = 0;
        if (hipGetDevice(&dev) != hipSuccess || hipDeviceGetAttribute(&cus, hipDeviceAttributeMultiprocessorCount, dev) != hipSuccess) { grid = -1; return; }
#if !MIXER_MFMA
        (void)hipFuncSetAttribute((const void*)mixer_dbg_kernel<0>, hipFuncAttributeMaxDynamicSharedMemorySize, LDS_BYTES);
        (void)hipFuncSetAttribute((const void*)mixer_dbg_kernel<1>, hipFuncAttributeMaxDynamicSharedMemorySize, LDS_BYTES);
        (void)hipFuncSetAttribute((const void*)mixer_dbg_kernel<2>, hipFuncAttributeMaxDynamicSharedMemorySize, LDS_BYTES);
        (void)hipFuncSetAttribute((const void*)mixer_dbg_kernel<3>, hipFuncAttributeMaxDynamicSharedMemorySize, LDS_BYTES);
#endif
        if (hipFuncSetAttribute((const void*)fwd_kernel, hipFuncAttributeMaxDynamicSharedMemorySize, LDS_BYTES) != hipSuccess) { fprintf(stderr, "kernel_launch: hipFuncSetAttribute failed\n"); grid = -1; return; }
        if (hipOccupancyMaxActiveBlocksPerMultiprocessor(&per_cu, (const void*)fwd_kernel, 512, LDS_BYTES) != hipSuccess || per_cu < 1) { fprintf(stderr, "kernel_launch: occupancy query says %d blocks per CU\n", per_cu); grid = -1; return; }
        (void)hipGetLastError();
        grid = cus * 1;
    }
    if (grid < 0) return;
    (void)hipMemsetAsync((char*)d_ws + WS_CTL, 0, CTL_ZERO_BYTES, stream);
    Args a{};
    for (int i = 0; i < 31; ++i) a.in[i] = (const float*)d_in[i];
    a.out = (float*)d_out; a.ws = (unsigned char*)d_ws;
#if MK_PER_PHASE
    for (int p = 0; p < NPHASE; ++p) { a.ph_lo = p; a.ph_hi = p + 1;
#if !MIXER_MFMA
        if (p == 6 && !MIX6) { hipLaunchKernelGGL(mixer_dbg_kernel<0>, dim3(grid), dim3(512), LDS_BYTES, stream, a); continue; }
        if (p == 7 && !MIX7) { hipLaunchKernelGGL(mixer_dbg_kernel<1>, dim3(grid), dim3(512), LDS_BYTES, stream, a); continue; }
        if (p == 8 && !MIX8) { hipLaunchKernelGGL(mixer_dbg_kernel<2>, dim3(grid), dim3(512), LDS_BYTES, stream, a); hipLaunchKernelGGL(mixer_dbg_kernel<3>, dim3(grid), dim3(512), LDS_BYTES, stream, a); continue; }
#endif
        hipLaunchKernelGGL(fwd_kernel, dim3(grid), dim3(512), LDS_BYTES, stream, a); }
#else
    a.ph_lo = 0; a.ph_hi = NPHASE;
    void* args[] = {&a};
    hipError_t e = hipLaunchCooperativeKernel((const void*)fwd_kernel, dim3(grid), dim3(512), args, LDS_BYTES, stream);
    if (e != hipSuccess) fprintf(stderr, "kernel_launch: cooperative launch failed: %s (grid %d)\n", hipGetErrorString(e), grid);
#endif
}
```

```cpp
#include <hip/hip_runtime.h>
#include <cstdio>
#include <cstdint>
namespace pg8 {
#define PG8_LAS __attribute__((address_space(3)))
typedef unsigned short bf16_t;
typedef short bf16x8 __attribute__((ext_vector_type(8)));
typedef float f32x4 __attribute__((ext_vector_type(4)));
typedef unsigned u32x4 __attribute__((ext_vector_type(4)));
constexpr int BM = 256, BK = 64, HALF = 128, HTB = HALF * BK * 2  , STAGE_BYTES = 8 * HTB, NXCD = 8, WGM = 8;

__host__ __device__ __forceinline__ int lds_byte(int r, int c) { const int st = (r >> 4) * 2 + (c >> 5), rr = r & 15, cc = c & 31, ob = rr * 64 + cc * 2; return st * 1024 + (ob ^ (((ob >> 9) & 1) << 5)); }
__host__ __device__ __forceinline__ void stage_rc(int b, int& R, int& C) { const int st = b / 1024, sb = b % 1024, swz = sb ^ (((sb >> 9) & 1) << 5); R = (st >> 1) * 16 + swz / 64; C = (st & 1) * 32 + (swz % 64) / 2; }
__host__ __device__ __forceinline__ int perm32(int rho) { const int n = rho >> 4, i = rho & 15; return 8 * (i >> 2) + 4 * n + (i & 3); }

struct Unit { int pm, pn; };
struct Gemm { const bf16_t* A; const bf16_t* Bt; int M, N, K, lda; };

struct StaticOrder {
    int nM, nN, nwg, G, c;
    __host__ __device__ void init(int M, int N, int G_, int c_) { nM = M / BM; nN = N / BM; nwg = nM * nN; G = G_; c = c_; }
    __host__ __device__ bool next(int i, Unit& u) const {
        const long L = (long)i * G + c; if (L >= nwg) return false;
        int wgid = (int)L; { const int q = nwg / NXCD, r = nwg % NXCD, xcd = wgid % NXCD, off = wgid / NXCD; wgid = (xcd < r ? xcd * (q + 1) : r * (q + 1) + (xcd - r) * q) + off; }
        const int nig = WGM * nN, gid = wgid / nig, fm = gid * WGM, gsz = (nM - fm) < WGM ? (nM - fm) : WGM;
        u.pm = fm + ((wgid % nig) % gsz); u.pn = (wgid % nig) / gsz; return true;
    }
    __device__ __forceinline__ void a_ready(const Unit&) const {}
    __device__ __forceinline__ void done(const Unit&) const {}
};

__device__ __forceinline__ unsigned cvt_pk_bf16(float lo, float hi) { unsigned r; asm volatile("v_cvt_pk_bf16_f32 %0, %1, %2" : "=v"(r) : "v"(lo), "v"(hi)); return r; }
template <class Epi, class Sched, bool ALIGN_EPI = false, bool SP2 = false>
__device__ __forceinline__ void gemm_phase(PG8_LAS unsigned char* lds, const Gemm g, const Sched& S, const Epi& E) {
    int tid_l = threadIdx.x; asm volatile("" : "+v"(tid_l)); const int tid = tid_l, wid = __builtin_amdgcn_readfirstlane(tid >> 6), lane = tid & 63, wr = wid >> 2, wc = wid & 3, fr = lane & 15, fq = lane >> 4;
    const int K = g.K, nt = K / BK;
    unsigned voffA[2], voffB[2];
#pragma unroll
    for (int i = 0; i < 2; ++i) { int R, C; stage_rc(tid * 16 + i * 8192, R, C); const int Rb = Epi::PERM ? ((R & ~31) + perm32(R & 31)) : R;
        voffA[i] = (unsigned)(R * g.lda + C) * 2u; voffB[i] = (unsigned)(Rb * K + C) * 2u; }
    const size_t kstep = (size_t)(BK * 2);
    const size_t hstep = (size_t)HALF * K * 2;
    const size_t tstep = 2 * hstep; const size_t hstepA = (size_t)HALF * g.lda * 2, tstepA = 2 * hstepA;
    const unsigned ldsw = (unsigned)wid * 1024u;
    const int aoff = lds_byte(wr * 64 + fr, fq * 8), boff = lds_byte(wc * 32 + fr, fq * 8);
#define PG8_SA(b, h) (((b) * 2 + (h)) * HTB)
#define PG8_SB(b, h) ((4 + (b) * 2 + (h)) * HTB)
#define PG8_STAGE(bufoff, gbase, voff) do { _Pragma("unroll") for (int _i = 0; _i < 2; ++_i) \
        __builtin_amdgcn_global_load_lds((const unsigned*)((const char*)(gbase) + (voff)[_i]), (PG8_LAS unsigned*)(lds + (bufoff) + ldsw + _i * 8192), 16, 0, 0); } while (0)
#define PG8_LDA(dst, b, h) do { _Pragma("unroll") for (int m = 0; m < 4; ++m) _Pragma("unroll") for (int k = 0; k < 2; ++k) dst[m][k] = *(const PG8_LAS bf16x8*)(lds + PG8_SA(b, h) + aoff + m * 2048 + k * 1024); } while (0)
#define PG8_LDB(dst, b, h) do { _Pragma("unroll") for (int n = 0; n < 2; ++n) _Pragma("unroll") for (int k = 0; k < 2; ++k) dst[n][k] = *(const PG8_LAS bf16x8*)(lds + PG8_SB(b, h) + boff + n * 2048 + k * 1024); } while (0)
#define PG8_MMA(ai, bj, At, Bt) do { __builtin_amdgcn_s_setprio(1); _Pragma("unroll") for (int m = 0; m < 4; ++m) _Pragma("unroll") for (int n = 0; n < 2; ++n) _Pragma("unroll") for (int k = 0; k < 2; ++k) \
        acc[ai][bj][m][n] = __builtin_amdgcn_mfma_f32_16x16x32_bf16(Bt[n][k], At[m][k], acc[ai][bj][m][n], 0, 0, 0); __builtin_amdgcn_s_setprio(0); } while (0)
#define PG8_WAIT_V(n) asm volatile("s_waitcnt vmcnt(" #n ")" ::: "memory")
#define PG8_WAIT_L(n) asm volatile("s_waitcnt lgkmcnt(" #n ")" ::: "memory")
#define PG8_BAR __builtin_amdgcn_s_barrier()
#define PG8_SCHED __builtin_amdgcn_sched_barrier(0)
    Unit cur, nxt; int ui = 0;
    if (!S.next(0, cur)) return;
    f32x4 acc[2][2][4][2];
#pragma unroll
    for (int a = 0; a < 2; ++a)
#pragma unroll
        for (int b = 0; b < 2; ++b)
#pragma unroll
            for (int m = 0; m < 4; ++m)
#pragma unroll
                for (int n = 0; n < 2; ++n) acc[a][b][m][n] = (f32x4){0.f, 0.f, 0.f, 0.f};
    bf16x8 At[4][2], B0[2][2], B1[2][2];
    const char* cA = (const char*)g.A + (size_t)cur.pm * tstepA; const char* cB = (const char*)g.Bt + (size_t)cur.pn * tstep;
    S.a_ready(cur);
    if constexpr (SP2) {
        PG8_STAGE(PG8_SB(0, 0), cB, voffB); PG8_STAGE(PG8_SB(0, 1), cB + hstep, voffB); PG8_STAGE(PG8_SA(0, 0), cA, voffA); PG8_STAGE(PG8_SA(0, 1), cA + hstepA, voffA);
        if (wr == 1) PG8_BAR;
        PG8_WAIT_V(2); PG8_BAR;
        PG8_STAGE(PG8_SB(1, 0), cB + kstep, voffB); PG8_STAGE(PG8_SA(1, 0), cA + kstep, voffA); PG8_STAGE(PG8_SB(1, 1), cB + hstep + kstep, voffB);
        PG8_WAIT_V(6); PG8_BAR;
    } else {
        PG8_STAGE(PG8_SB(0, 0), cB, voffB); PG8_STAGE(PG8_SA(0, 0), cA, voffA); PG8_STAGE(PG8_SB(0, 1), cB + hstep, voffB); PG8_STAGE(PG8_SA(0, 1), cA + hstepA, voffA);
        if (wr == 1) PG8_BAR;
        PG8_WAIT_V(4); PG8_BAR;
        PG8_STAGE(PG8_SB(1, 0), cB + kstep, voffB); PG8_STAGE(PG8_SA(1, 0), cA + kstep, voffA); PG8_STAGE(PG8_SB(1, 1), cB + hstep + kstep, voffB);
        PG8_WAIT_V(6); PG8_BAR;
    }
    for (;;) {
        const bool has_next = S.next(ui + 1, nxt);
        const char* nA = has_next ? (const char*)g.A + (size_t)nxt.pm * tstepA : cA; const char* nB = has_next ? (const char*)g.Bt + (size_t)nxt.pn * tstep : cB;
        for (int t = 0; t < nt; t += 2) {
            const bool last = (t == nt - 2);
            const char* a1 = cA + (size_t)(t + 1) * kstep;
            const char* a2 = last ? nA : cA + (size_t)(t + 2) * kstep; const char* b2 = last ? nB : cB + (size_t)(t + 2) * kstep;
            const char* a3 = a2 + kstep; const char* b3 = b2 + kstep;
            if (last && has_next) S.a_ready(nxt);
            if constexpr (SP2) {
            PG8_LDB(B0, 0, 0); PG8_LDB(B1, 0, 1); PG8_SCHED; PG8_LDA(At, 0, 0); PG8_STAGE(PG8_SA(1, 1), a1 + hstepA, voffA);
            PG8_WAIT_V(8); PG8_WAIT_L(0); PG8_BAR; PG8_MMA(0, 0, At, B0); PG8_MMA(0, 1, At, B1); PG8_BAR; PG8_SCHED;
            PG8_LDA(At, 0, 1); PG8_STAGE(PG8_SB(0, 0), b2, voffB); PG8_STAGE(PG8_SB(0, 1), b2 + hstep, voffB); PG8_STAGE(PG8_SA(0, 0), a2, voffA);
            PG8_WAIT_V(8); PG8_WAIT_L(0); PG8_BAR; PG8_MMA(1, 0, At, B0); PG8_MMA(1, 1, At, B1); PG8_BAR; PG8_SCHED;
            PG8_LDB(B0, 1, 0); PG8_LDB(B1, 1, 1); PG8_SCHED; PG8_LDA(At, 1, 0); PG8_STAGE(PG8_SA(0, 1), a2 + hstepA, voffA);
            PG8_WAIT_V(8); PG8_WAIT_L(0); PG8_BAR; PG8_MMA(0, 0, At, B0); PG8_MMA(0, 1, At, B1); PG8_BAR; PG8_SCHED;
            PG8_LDA(At, 1, 1); PG8_STAGE(PG8_SB(1, 0), b3, voffB); PG8_STAGE(PG8_SB(1, 1), b3 + hstep, voffB); PG8_STAGE(PG8_SA(1, 0), a3, voffA);
            PG8_WAIT_V(8); PG8_WAIT_L(0); PG8_BAR; PG8_MMA(1, 0, At, B0); PG8_MMA(1, 1, At, B1); PG8_BAR; PG8_SCHED;
            } else {
            PG8_LDB(B0, 0, 0); PG8_SCHED; PG8_LDA(At, 0, 0); PG8_STAGE(PG8_SA(1, 1), a1 + hstepA, voffA);
            PG8_WAIT_L(8); PG8_BAR; PG8_WAIT_L(0); PG8_MMA(0, 0, At, B0); PG8_BAR; PG8_SCHED;
            PG8_LDB(B1, 0, 1); PG8_STAGE(PG8_SB(0, 0), b2, voffB);
            PG8_BAR; PG8_WAIT_L(0); PG8_MMA(0, 1, At, B1); PG8_BAR;
            PG8_LDA(At, 0, 1); PG8_STAGE(PG8_SA(0, 0), a2, voffA);
            PG8_BAR; PG8_WAIT_L(0); PG8_MMA(1, 0, At, B0); PG8_BAR; PG8_SCHED;
            PG8_STAGE(PG8_SB(0, 1), b2 + hstep, voffB);
            PG8_WAIT_V(6); PG8_BAR; PG8_MMA(1, 1, At, B1); PG8_BAR;
            PG8_LDB(B0, 1, 0); PG8_SCHED; PG8_LDA(At, 1, 0); PG8_STAGE(PG8_SA(0, 1), a2 + hstepA, voffA);
            PG8_WAIT_L(8); PG8_BAR; PG8_WAIT_L(0); PG8_MMA(0, 0, At, B0); PG8_BAR; PG8_SCHED;
            PG8_LDB(B1, 1, 1); PG8_STAGE(PG8_SB(1, 0), b3, voffB);
            PG8_BAR; PG8_WAIT_L(0); PG8_MMA(0, 1, At, B1); PG8_BAR;
            PG8_LDA(At, 1, 1); PG8_STAGE(PG8_SA(1, 0), a3, voffA);
            PG8_BAR; PG8_WAIT_L(0); PG8_MMA(1, 0, At, B0); PG8_BAR; PG8_SCHED;
            PG8_STAGE(PG8_SB(1, 1), b3 + hstep, voffB);
            PG8_WAIT_V(6); PG8_BAR; PG8_MMA(1, 1, At, B1); PG8_BAR;
            }
        }
        if constexpr (ALIGN_EPI) { if (wr == 0) PG8_BAR; }
        if constexpr (!Epi::AFTER_DRAIN) { E(acc, cur, wr, wc, fr, fq); S.done(cur); }
        if (!has_next) break;
#pragma unroll
        for (int a = 0; a < 2; ++a)
#pragma unroll
            for (int b = 0; b < 2; ++b)
#pragma unroll
                for (int m = 0; m < 4; ++m)
#pragma unroll
                    for (int n = 0; n < 2; ++n) acc[a][b][m][n] = (f32x4){0.f, 0.f, 0.f, 0.f};
        cur = nxt; cA = nA; cB = nB; ++ui;
        if constexpr (ALIGN_EPI) { if (wr == 1) PG8_BAR; }
    }
    PG8_WAIT_V(0);
    if constexpr (!ALIGN_EPI) { if (wr == 0) PG8_BAR; }
    PG8_BAR;
    if constexpr (Epi::AFTER_DRAIN) { E.fused(acc, cur, wr, wc, fr, fq, lds, wid, lane); S.done(cur); }
#undef PG8_SA
#undef PG8_SB
#undef PG8_STAGE
#undef PG8_LDA
#undef PG8_LDB
#undef PG8_MMA
#undef PG8_WAIT_V
#undef PG8_WAIT_L
#undef PG8_BAR
#undef PG8_SCHED
}
}

constexpr int D = 1024, NCTX = 4096, MROWS = 12288, FF = 2816;
constexpr int CH = 128, NCHUNK = 96, NHEAD = 4;
constexpr int PA_LD = 4096;
constexpr int C_RQ = 0, C_RK = 512, C_RV = 1024, C_MQ = 2048, C_MK = 2560, C_MV = 3072, C_MO = 3584;
constexpr int MODW = 9216;
constexpr float EPS_RMS = 1e-6f, EPS_GN = 1e-5f;
constexpr size_t OUT_Y = 0, OUT_SRET = (size_t)MROWS * D, OUT_SC = OUT_SRET + 16ull * 2 * 4 * 128 * 256, OUT_SN = OUT_SC + 16ull * 2 * 4 * 128 * 128, OUT_SM = OUT_SN + 16ull * 2 * 4 * 128, OUT_END = OUT_SM + 128;
constexpr size_t MiB = 1u << 20, KiB = 1024;
constexpr size_t WS_CTL = 0, CTL_ZERO_BYTES = 64 * KiB;
constexpr size_t WS_MOD = 1 * MiB;
constexpr size_t WS_WG = 1 * MiB + 384 * KiB;
constexpr size_t WS_ROPE = 2 * MiB;
constexpr size_t WS_IG = 2 * MiB + 512 * KiB;
constexpr size_t WS_LF = WS_IG + 384 * KiB;
constexpr size_t WS_MN = WS_LF + 384 * KiB;
constexpr size_t WS_MS = WS_MN + 384 * KiB;
constexpr size_t WS_W13A = 4 * MiB, WS_W2A = 15 * MiB, WS_W13B = 20 * MiB + 512 * KiB, WS_W2B = 31 * MiB + 512 * KiB;
constexpr size_t WS_WIN = 37 * MiB, WS_WR = 51 * MiB, WS_WM = 53 * MiB, WS_WO = 54 * MiB;
constexpr size_t WS_U = 56 * MiB;
constexpr size_t WS_BIG = 80 * MiB;
constexpr size_t WS_H = WS_BIG;
constexpr size_t WS_PA = WS_BIG;
constexpr size_t WS_RS = 176 * MiB;
constexpr size_t WS_MC = 224 * MiB;
constexpr size_t WS_BG = WS_RS;
constexpr size_t WS_T1 = WS_MC;
constexpr size_t WS_END = 248 * MiB;
static_assert(WS_MS + 16 * KiB <= WS_W13A, "ws map");
constexpr int CW_BAR = 1024;

constexpr int LDS_BYTES = 147456;
constexpr int RING_BYTES = 131072;
constexpr int MISC_OFF = LDS_BYTES - 256;

#define GAS __attribute__((address_space(1)))
#define LAS __attribute__((address_space(3)))
typedef unsigned short bf16;
typedef unsigned v4u __attribute__((ext_vector_type(4)));
typedef unsigned v2u __attribute__((ext_vector_type(2)));
typedef float f32x4 __attribute__((ext_vector_type(4)));
typedef GAS unsigned gu32;
#define RLX_AGENT __ATOMIC_RELAXED, __HIP_MEMORY_SCOPE_AGENT
#define LDS_WAIT() asm volatile("s_waitcnt lgkmcnt(0)" ::: "memory")
#define VM_WAIT() asm volatile("s_waitcnt vmcnt(0)" ::: "memory")
__device__ __forceinline__ unsigned f2bf(float f) { unsigned u = __builtin_bit_cast(unsigned, f); return (u + 0x7fffu + ((u >> 16) & 1u)) >> 16; }
__device__ __forceinline__ unsigned pk2(float lo, float hi) { return f2bf(lo) | (f2bf(hi) << 16); }
__device__ __forceinline__ float bf2f(unsigned short b) { return __builtin_bit_cast(float, (unsigned)b << 16); }
__device__ __forceinline__ float bflo(unsigned w) { return __builtin_bit_cast(float, w << 16); }
__device__ __forceinline__ float bfhi(unsigned w) { return __builtin_bit_cast(float, w & 0xffff0000u); }
__device__ __forceinline__ float silu_f(float x) { return x / (1.f + __expf(-x)); }
__device__ __forceinline__ float sigmoid_f(float x) { return 1.f / (1.f + __expf(-x)); }
__device__ __forceinline__ float logsigmoid_f(float x) { return fminf(x, 0.f) - log1pf(expf(-fabsf(x))); }
__device__ __forceinline__ float wave_sum(float v) {
#pragma unroll
    for (int o = 1; o < 64; o <<= 1) v += __shfl_xor(v, o);
    return v;
}
#define XB_TMO      128
#define XB_XCNT(j)  (256  + 64 * (j))
#define XB_XSUB(j)  (1280 + 64 * (j))
#define XB_XGEN(j)  (2304 + 64 * (j))
#define XB_TOP      3328
#define XB_TOPGEN   3392
#define XCD_BAR_WORDS 3456
#define XB_SPIN_CAP (1u << 18)

__device__ __forceinline__ unsigned xb_ld(unsigned* p)              { return __hip_atomic_load(p, __ATOMIC_RELAXED, __HIP_MEMORY_SCOPE_AGENT); }
__device__ __forceinline__ unsigned xb_add(unsigned* p, unsigned v) { return __hip_atomic_fetch_add(p, v, __ATOMIC_RELAXED, __HIP_MEMORY_SCOPE_AGENT); }
__device__ __forceinline__ unsigned xb_xcc_id() { return (unsigned)__builtin_amdgcn_s_getreg((3 << 11) | 20) & 0xFu; }
#define XB_SPIN(cond, bar) do { unsigned _sp = 0; while (cond) { __builtin_amdgcn_s_sleep(1); \
    if ((++_sp & 255u) == 0u) { if (xb_ld(&(bar)[XB_TMO])) break; if (_sp > XB_SPIN_CAP) { atomicAdd(&(bar)[XB_TMO], 1u); break; } } } } while (0)

struct XcdBarrier {
    unsigned* bar; unsigned x;
    volatile LAS unsigned* st;
};

__device__ __forceinline__ XcdBarrier xcd_barrier_post(unsigned* bar, volatile LAS unsigned* st) {
    XcdBarrier b; b.bar = bar; b.x = xb_xcc_id(); b.st = st;
    if (threadIdx.x == 0) (void)xb_add(&bar[XB_XCNT(b.x)], 1u);
    return b;
}
__device__ __forceinline__ void xcd_barrier_complete(unsigned* bar, unsigned x, unsigned& nloc, unsigned& nx) {
    const unsigned G = gridDim.x * gridDim.y * gridDim.z;
    unsigned sum, cnt, mine, sp = 0u;
    for (;;) {
        sum = 0u; cnt = 0u; mine = 0u;
#pragma unroll
        for (unsigned j = 0; j < 16; ++j) { const unsigned c = xb_ld(&bar[XB_XCNT(j)]); sum += c; cnt += (c > 0u) ? 1u : 0u; mine = (j == x) ? c : mine; }
        if (sum == G) break;
        __builtin_amdgcn_s_sleep(1);
        if ((++sp & 255u) == 0u) { if (xb_ld(&bar[XB_TMO])) break; if (sp > XB_SPIN_CAP) { atomicAdd(&bar[XB_TMO], 1u); break; } }
    }
    nloc = mine > 0u ? mine : 1u; nx = cnt > 0u ? cnt : 1u;
}

__device__ __forceinline__ void xcd_barrier(const XcdBarrier& b) {
    asm volatile("s_waitcnt vmcnt(0)" ::: "memory");
    __syncthreads();
    if (threadIdx.x == 0) {
        unsigned* bar = b.bar;
        __builtin_amdgcn_s_waitcnt(0);
        unsigned nloc = b.st[0], nx = b.st[1];
        if (nloc == 0u) { xcd_barrier_complete(bar, b.x, nloc, nx); b.st[0] = nloc; b.st[1] = nx; }
        const unsigned old = xb_add(&bar[XB_XSUB(b.x)], 1u);
        const unsigned gen = old / nloc;
        if (old + 1u == (gen + 1u) * nloc) {
            __builtin_amdgcn_fence(__ATOMIC_RELEASE, "agent");
            asm volatile("s_waitcnt vmcnt(0)" ::: "memory");
            const unsigned og = xb_add(&bar[XB_TOP], 1u);
            const unsigned tg = og / nx;
            if (og + 1u == (tg + 1u) * nx) xb_add(&bar[XB_TOPGEN], 1u);
            else XB_SPIN(xb_ld(&bar[XB_TOPGEN]) == tg, bar);
            __builtin_amdgcn_fence(__ATOMIC_ACQUIRE, "agent");
            xb_add(&bar[XB_XGEN(b.x)], 1u);
            asm volatile("s_waitcnt vmcnt(0)" ::: "memory");
        } else {
            XB_SPIN(xb_ld(&bar[XB_XGEN(b.x)]) == gen, bar);
            __builtin_amdgcn_fence(__ATOMIC_ACQUIRE, "agent");
            asm volatile("s_waitcnt vmcnt(0)" ::: "memory");
        }
    }
    __syncthreads();
}

struct Args { const float* in[31]; float* out; unsigned char* ws; int ph_lo, ph_hi; };
enum { I_XP = 0, I_XS, I_C, I_SRET, I_SC, I_SN, I_SM, I_CCTX, I_WADA, I_BADA, I_NF1, I_W1A, I_W3A, I_W2A, I_NMIX, I_WIN, I_CONVW, I_CONVB,
       I_DECAY, I_BIG, I_BFG, I_RETGN, I_MGN, I_WRUP, I_WMUP, I_WOUT, I_NF2, I_W1B, I_W3B, I_W2B, I_NFIN };

struct Frame {
    unsigned char* lds;
    int tid, lane, wave, G, bid, gw, ngw;
};

__device__ __forceinline__ int mod_row(int row) { return row < NCTX ? 0 : 1 + ((row - NCTX) >> 10); }

__device__ __forceinline__ int rope_perm(int p) { const int s = p >> 6, i = p & 63; return 8 * (i >> 2) + 4 * s + (i & 3); }
template <int MODE>
__device__ __forceinline__ void p0_tr_item(const float* W, int ldw, int col0, int K, int ncols, bf16* WT, int row_off, float* scr, int item, int lane) {
    const int nblk = ncols / 32, kb = item / nblk, nb = item % nblk, k0 = 64 * kb, n0 = 32 * nb;
#pragma unroll 8
    for (int i = 0; i < 32; ++i) { const int kk = 2 * i + (lane >> 5); scr[kk * 33 + (lane & 31)] = W[(size_t)(k0 + kk) * ldw + col0 + n0 + (lane & 31)]; }
    LDS_WAIT(); asm volatile("" ::: "memory");
    const int c = lane & 7;
#pragma unroll
    for (int j = 0; j < 4; ++j) { const int n = (lane >> 3) + 8 * j, nn = n0 + n; const float* s = scr + (8 * c) * 33 + n;
        int drow;
        if (MODE == 0) drow = row_off + nn; else if (MODE == 1) drow = row_off + (nn & ~127) + rope_perm(nn & 127); else drow = row_off + 256 * (nn >> 7) + (nn & 127);
        v4u o; o.x = pk2(s[0 * 33], s[1 * 33]); o.y = pk2(s[2 * 33], s[3 * 33]); o.z = pk2(s[4 * 33], s[5 * 33]); o.w = pk2(s[6 * 33], s[7 * 33]);
        *(v4u*)(WT + (size_t)drow * K + k0 + 8 * c) = o; }
    LDS_WAIT(); asm volatile("" ::: "memory");
}

__device__ __forceinline__ void p0_prologue(const Args& a, const Frame& F) {
    unsigned char* ws = a.ws;
    float* mod = (float*)(ws + WS_MOD);
    if (F.bid < MODW / 64) {
        float* sc = (float*)F.lds;
        float* part = (float*)(F.lds + 40960);
        for (int idx = F.tid; idx < 9 * 1024; idx += 512) { const int r = idx >> 10, k = idx & 1023; const float v = r == 0 ? a.in[I_CCTX][k] : a.in[I_C][(r - 1) * 1024 + k]; sc[idx] = v / (1.f + expf(-v)); }
        __syncthreads();
        const int c0 = 64 * F.bid, k0 = 128 * F.wave; const float* wp = a.in[I_WADA] + (size_t)k0 * MODW + c0 + F.lane;
        float acc[9];
#pragma unroll
        for (int r = 0; r < 9; ++r) acc[r] = 0.f;
#pragma unroll 16
        for (int kk = 0; kk < 128; ++kk) { const float wv = wp[(size_t)kk * MODW];
#pragma unroll
            for (int r = 0; r < 9; ++r) acc[r] += sc[r * 1024 + k0 + kk] * wv; }
#pragma unroll
        for (int r = 0; r < 9; ++r) part[(F.wave * 9 + r) * 64 + F.lane] = acc[r];
        __syncthreads();
        for (int idx = F.tid; idx < 9 * 64; idx += 512) { const int r = idx >> 6, l = idx & 63; float s = 0.f;
#pragma unroll
            for (int w = 0; w < 8; ++w) s += part[(w * 9 + r) * 64 + l];
            mod[r * MODW + c0 + l] = s + a.in[I_BADA][c0 + l]; }
        __syncthreads();
    }
    { float* wg = (float*)(ws + WS_WG); const int gt = F.bid * 512 + F.tid, ngt = F.G * 512;
      for (int idx = gt; idx < 16 * 1024; idx += ngt) { const int c = idx >> 10, k = idx & 1023; wg[idx] = a.in[I_WIN][(size_t)k * 7184 + 5120 + c]; }
      float2* rope = (float2*)(ws + WS_ROPE);
      for (int idx = gt; idx < 1024 * 64; idx += ngt) { const int t = idx >> 6, i = idx & 63, f = i & 31; const float freq = exp2f(-(float)f * (13.287712379549449f / 32.f));
          const float pos = (float)(i < 32 ? (t >> 6) : (t & 63)); const float ang = pos * freq; rope[idx] = make_float2(cosf(ang), sinf(ang)); } }
    float* scr = (float*)(F.lds + F.wave * 16384);
    bf16* W13A = (bf16*)(ws + WS_W13A); bf16* W2A = (bf16*)(ws + WS_W2A); bf16* W13B = (bf16*)(ws + WS_W13B); bf16* W2B = (bf16*)(ws + WS_W2B);
    bf16* WIN = (bf16*)(ws + WS_WIN); bf16* WR = (bf16*)(ws + WS_WR); bf16* WM = (bf16*)(ws + WS_WM); bf16* WO = (bf16*)(ws + WS_WO);
    constexpr int I_UP = 16 * 88, I_DN = 44 * 32, I_512 = 16 * 32, I_1024 = 16 * 64, I_MUP = 8 * 32;
    constexpr int NITEMS = 4 * I_UP + 2 * I_DN + (I_512 + I_512 + I_1024 + I_512 + I_1024) + I_512 + I_MUP + I_512;
    for (int it = F.gw; it < NITEMS; it += F.ngw) {
        int r = it;
        if (r < I_UP) { p0_tr_item<2>(a.in[I_W1A], FF, 0, D, FF, W13A, 0, scr, r, F.lane); continue; } r -= I_UP;
        if (r < I_UP) { p0_tr_item<2>(a.in[I_W3A], FF, 0, D, FF, W13A, 128, scr, r, F.lane); continue; } r -= I_UP;
        if (r < I_DN) { p0_tr_item<0>(a.in[I_W2A], D, 0, FF, D, W2A, 0, scr, r, F.lane); continue; } r -= I_DN;
        if (r < I_UP) { p0_tr_item<2>(a.in[I_W1B], FF, 0, D, FF, W13B, 0, scr, r, F.lane); continue; } r -= I_UP;
        if (r < I_UP) { p0_tr_item<2>(a.in[I_W3B], FF, 0, D, FF, W13B, 128, scr, r, F.lane); continue; } r -= I_UP;
        if (r < I_DN) { p0_tr_item<0>(a.in[I_W2B], D, 0, FF, D, W2B, 0, scr, r, F.lane); continue; } r -= I_DN;
        if (r < I_512) { p0_tr_item<1>(a.in[I_WIN], 7184, 0, D, 1024, WIN, 0, scr, r, F.lane); continue; } r -= I_512;
        if (r < I_512) { p0_tr_item<0>(a.in[I_WIN], 7184, 1024, D, 1024, WIN, 1024, scr, r, F.lane); continue; } r -= I_512;
        if (r < I_1024) { p0_tr_item<0>(a.in[I_WIN], 7184, 3072, D, 2048, WIN, 2048, scr, r, F.lane); continue; } r -= I_1024;
        if (r < I_512) { p0_tr_item<0>(a.in[I_WIN], 7184, 2048, D, 1024, WIN, 4096, scr, r, F.lane); continue; } r -= I_512;
        if (r < I_1024) { p0_tr_item<0>(a.in[I_WIN], 7184, 5136, D, 2048, WIN, 5120, scr, r, F.lane); continue; } r -= I_1024;
        if (r < I_512) { p0_tr_item<0>(a.in[I_WRUP], D, 0, D, D, WR, 0, scr, r, F.lane); continue; } r -= I_512;
        if (r < I_MUP) { p0_tr_item<0>(a.in[I_WMUP], D, 0, 512, D, WM, 0, scr, r, F.lane); continue; } r -= I_MUP;
        p0_tr_item<0>(a.in[I_WOUT], D, 0, D, D, WO, 0, scr, r, F.lane);
    }
}

template <bool GATES>
__device__ __forceinline__ void norm_phase(const Args& a, const Frame& F, const float* x0, const float* x1, const float* nw, int sh_off, int sc_off) {
    const float* mod = (const float*)(a.ws + WS_MOD); bf16* U = (bf16*)(a.ws + WS_U);
    float* wgs = (float*)F.lds;
    if (GATES) { const float* wg = (const float*)(a.ws + WS_WG); for (int i = F.tid; i < 16 * 1024 / 4; i += 512) ((f32x4*)wgs)[i] = ((const f32x4*)wg)[i]; __syncthreads(); }
    f32x4 nwv[4];
#pragma unroll
    for (int j = 0; j < 4; ++j) nwv[j] = ((const f32x4*)nw)[F.lane + 64 * j];
    for (int row = F.gw; row < MROWS; row += F.ngw) {
        const float* xr = row < NCTX ? x0 + (size_t)row * D : x1 + (size_t)(row - NCTX) * D;
        const int mr = mod_row(row); const float* shp = mod + mr * MODW + sh_off; const float* scp = mod + mr * MODW + sc_off;
        f32x4 v[4]; float ss = 0.f;
#pragma unroll
        for (int j = 0; j < 4; ++j) { v[j] = ((const f32x4*)xr)[F.lane + 64 * j]; ss += (v[j].x * v[j].x + v[j].y * v[j].y) + (v[j].z * v[j].z + v[j].w * v[j].w); }
        const float rstd = 1.f / sqrtf(wave_sum(ss) * (1.f / D) + EPS_RMS);
        unsigned long long* o8 = (unsigned long long*)(U + (size_t)row * D) + F.lane;
#pragma unroll
        for (int j = 0; j < 4; ++j) { const f32x4 sh = ((const f32x4*)shp)[F.lane + 64 * j], sc = ((const f32x4*)scp)[F.lane + 64 * j];
            v[j] = v[j] * rstd * nwv[j] * (sc + 1.f) + sh;
            o8[64 * j] = (unsigned long long)pk2(v[j].x, v[j].y) | ((unsigned long long)pk2(v[j].z, v[j].w) << 32); }
        if (GATES) {
            float* IG = (float*)(a.ws + WS_IG); float* LF = (float*)(a.ws + WS_LF); float mine = 0.f;
#pragma unroll 1
            for (int c = 0; c < 16; ++c) { float p = 0.f;
#pragma unroll
                for (int j = 0; j < 4; ++j) { const f32x4 w = ((const f32x4*)(wgs + c * 1024))[F.lane + 64 * j]; p += (v[j].x * w.x + v[j].y * w.y) + (v[j].z * w.z + v[j].w * w.w); }
                p = wave_sum(p); if (F.lane == c) mine = p; }
            if (F.lane < 8) IG[(size_t)row * 8 + F.lane] = mine + a.in[I_BIG][F.lane];
            else if (F.lane < 16) LF[(size_t)row * 8 + F.lane - 8] = logsigmoid_f(mine + a.in[I_BFG][F.lane - 8]);
        }
    }
    if (GATES) __syncthreads();
}
__device__ __forceinline__ void final_norm_phase(const Args& a, const Frame& F) {
    f32x4 nwv[4];
#pragma unroll
    for (int j = 0; j < 4; ++j) nwv[j] = ((const f32x4*)a.in[I_NFIN])[F.lane + 64 * j];
    for (int row = F.gw; row < MROWS; row += F.ngw) {
        f32x4* xr = (f32x4*)(a.out + (size_t)row * D); f32x4 v[4]; float ss = 0.f;
#pragma unroll
        for (int j = 0; j < 4; ++j) { v[j] = xr[F.lane + 64 * j]; ss += (v[j].x * v[j].x + v[j].y * v[j].y) + (v[j].z * v[j].z + v[j].w * v[j].w); }
        const float rstd = 1.f / sqrtf(wave_sum(ss) * (1.f / D) + EPS_RMS);
#pragma unroll
        for (int j = 0; j < 4; ++j) xr[F.lane + 64 * j] = v[j] * rstd * nwv[j];
    }
}

using pg8::f32x4; using pg8::Unit; using pg8::cvt_pk_bf16;
struct EpiSwiGLU {
    static constexpr bool PERM = true, AFTER_DRAIN = false; bf16* H;
    __device__ __forceinline__ void operator()(const pg8::f32x4 (&acc)[2][2][4][2], const Unit& u, int wr, int wc, int fr, int fq) const {
        const int row0 = u.pm * 256 + wr * 64 + fr, col0 = u.pn * 128 + wc * 32 + 8 * fq;
#pragma unroll
        for (int ai = 0; ai < 2; ++ai)
#pragma unroll
            for (int m = 0; m < 4; ++m) { bf16* rowp = H + (size_t)(row0 + ai * 128 + m * 16) * FF + col0;
                const pg8::f32x4 g0 = acc[ai][0][m][0], g1 = acc[ai][0][m][1], u0 = acc[ai][1][m][0], u1 = acc[ai][1][m][1];
                v4u w; w.x = cvt_pk_bf16(silu_f(g0[0]) * u0[0], silu_f(g0[1]) * u0[1]); w.y = cvt_pk_bf16(silu_f(g0[2]) * u0[2], silu_f(g0[3]) * u0[3]);
                w.z = cvt_pk_bf16(silu_f(g1[0]) * u1[0], silu_f(g1[1]) * u1[1]); w.w = cvt_pk_bf16(silu_f(g1[2]) * u1[2], silu_f(g1[3]) * u1[3]);
                *(v4u*)rowp = w; }
    }
};
struct EpiResid {
    static constexpr bool PERM = false, AFTER_DRAIN = false; const float* base0; const float* base1; float* X; const float* gate; float scale;
    __device__ __forceinline__ void operator()(const pg8::f32x4 (&acc)[2][2][4][2], const Unit& u, int wr, int wc, int fr, int fq) const {
        const int row0 = u.pm * 256 + wr * 64 + fr, col0 = u.pn * 256 + wc * 32 + 4 * fq; const int mr = mod_row(u.pm * 256);
        pg8::f32x4 gv[2][2];
#pragma unroll
        for (int bj = 0; bj < 2; ++bj)
#pragma unroll
            for (int n = 0; n < 2; ++n) gv[bj][n] = *(const pg8::f32x4*)(gate + mr * MODW + col0 + bj * 128 + n * 16) * scale;
#pragma unroll
        for (int ai = 0; ai < 2; ++ai)
#pragma unroll
            for (int m = 0; m < 4; ++m) { const int row = row0 + ai * 128 + m * 16;
                const float* bp = (row < NCTX ? base0 + (size_t)row * D : base1 + (size_t)(row - NCTX) * D) + col0; float* xp = X + (size_t)row * D + col0;
#pragma unroll
                for (int bj = 0; bj < 2; ++bj)
#pragma unroll
                    for (int n = 0; n < 2; ++n) { const pg8::f32x4 b = *(const pg8::f32x4*)(bp + bj * 128 + n * 16); *(pg8::f32x4*)(xp + bj * 128 + n * 16) = b + gv[bj][n] * acc[ai][bj][m][n]; } }
    }
};
struct EpiProjA {
    static constexpr bool PERM = true, AFTER_DRAIN = false; bf16* P; const float2* rope;
    __device__ __forceinline__ void operator()(const pg8::f32x4 (&acc)[2][2][4][2], const Unit& u, int wr, int wc, int fr, int fq) const {
        const int row0 = u.pm * 256 + wr * 64 + fr;
        if (u.pn < 4) {
            const bool isk = u.pn >= 2, lat = u.pm >= 16; const float scl = isk ? 0.08838834764831845f : 1.f; const int q4 = 4 * wc + fq;
#pragma unroll
            for (int ai = 0; ai < 2; ++ai)
#pragma unroll
                for (int m = 0; m < 4; ++m) { const int row = row0 + ai * 128 + m * 16; const int t = (row - NCTX) & 1023;
#pragma unroll
                    for (int bj = 0; bj < 2; ++bj) { const int hh = 2 * (u.pn & 1) + bj; bf16* op = P + (size_t)row * PA_LD + (isk ? C_RK : C_RQ) + 128 * hh + 4 * q4;
                        pg8::f32x4 x1 = acc[ai][bj][m][0] * scl, x2 = acc[ai][bj][m][1] * scl;
                        if (lat) { const float2* cs = rope + t * 64 + 4 * q4;
#pragma unroll
                            for (int j = 0; j < 4; ++j) { const float2 c = cs[j]; const float a1 = x1[j], a2 = x2[j]; x1[j] = a1 * c.x - a2 * c.y; x2[j] = a2 * c.x + a1 * c.y; } }
                        v2u w1, w2; w1.x = cvt_pk_bf16(x1[0], x1[1]); w1.y = cvt_pk_bf16(x1[2], x1[3]); w2.x = cvt_pk_bf16(x2[0], x2[1]); w2.y = cvt_pk_bf16(x2[2], x2[3]);
                        *(v2u*)op = w1; *(v2u*)(op + 64) = w2; } }
        } else {
            const bool sg = u.pn >= 14; const int col0 = u.pn * 256 + wc * 32 + 8 * fq;
#pragma unroll
            for (int ai = 0; ai < 2; ++ai)
#pragma unroll
                for (int m = 0; m < 4; ++m) { bf16* rowp = P + (size_t)(row0 + ai * 128 + m * 16) * PA_LD + col0;
#pragma unroll
                    for (int bj = 0; bj < 2; ++bj) { pg8::f32x4 v0 = acc[ai][bj][m][0], v1 = acc[ai][bj][m][1];
                        if (sg) {
#pragma unroll
                            for (int j = 0; j < 4; ++j) { v0[j] = sigmoid_f(v0[j]); v1[j] = sigmoid_f(v1[j]); } }
                        v4u w; w.x = cvt_pk_bf16(v0[0], v0[1]); w.y = cvt_pk_bf16(v0[2], v0[3]); w.z = cvt_pk_bf16(v1[0], v1[1]); w.w = cvt_pk_bf16(v1[2], v1[3]);
                        *(v4u*)(rowp + bj * 128) = w; } }
        }
    }
};
struct EpiProjB {
    static constexpr bool PERM = true, AFTER_DRAIN = false; bf16* P; bf16* BG;
    __device__ __forceinline__ void operator()(const pg8::f32x4 (&acc)[2][2][4][2], const Unit& u, int wr, int wc, int fr, int fq) const {
        const int row0 = u.pm * 256 + wr * 64 + fr;
#pragma unroll
        for (int ai = 0; ai < 2; ++ai)
#pragma unroll
            for (int m = 0; m < 4; ++m) { const int row = row0 + ai * 128 + m * 16;
#pragma unroll
                for (int bj = 0; bj < 2; ++bj) { pg8::f32x4 v0 = acc[ai][bj][m][0], v1 = acc[ai][bj][m][1];
                    if (u.pn < 4) { bf16* p = P + (size_t)row * PA_LD + C_RV + u.pn * 256 + bj * 128 + wc * 32 + 8 * fq; const v4u r = *(const v4u*)p;
                        v4u w; w.x = cvt_pk_bf16(bflo(r.x) * silu_f(v0[0]), bfhi(r.x) * silu_f(v0[1])); w.y = cvt_pk_bf16(bflo(r.y) * silu_f(v0[2]), bfhi(r.y) * silu_f(v0[3]));
                        w.z = cvt_pk_bf16(bflo(r.z) * silu_f(v1[0]), bfhi(r.z) * silu_f(v1[1])); w.w = cvt_pk_bf16(bflo(r.w) * silu_f(v1[2]), bfhi(r.w) * silu_f(v1[3]));
                        *(v4u*)p = w;
                    } else { bf16* p = BG + (size_t)row * 2048 + (u.pn - 4) * 256 + bj * 128 + wc * 32 + 8 * fq;
                        v4u w; w.x = cvt_pk_bf16(sigmoid_f(v0[0]), sigmoid_f(v0[1])); w.y = cvt_pk_bf16(sigmoid_f(v0[2]), sigmoid_f(v0[3]));
                        w.z = cvt_pk_bf16(sigmoid_f(v1[0]), sigmoid_f(v1[1])); w.w = cvt_pk_bf16(sigmoid_f(v1[2]), sigmoid_f(v1[3]));
                        *(v4u*)p = w; } } }
    }
};
template <bool SECOND> struct EpiMerge {
    static constexpr bool PERM = true, AFTER_DRAIN = false; const bf16* BG; bf16* T1; bf16* OUT;
    __device__ __forceinline__ void operator()(const pg8::f32x4 (&acc)[2][2][4][2], const Unit& u, int wr, int wc, int fr, int fq) const {
        const int row0 = u.pm * 256 + wr * 64 + fr;
#pragma unroll
        for (int ai = 0; ai < 2; ++ai)
#pragma unroll
            for (int m = 0; m < 4; ++m) { const int row = row0 + ai * 128 + m * 16;
#pragma unroll
                for (int bj = 0; bj < 2; ++bj) { const int col = u.pn * 256 + bj * 128 + wc * 32 + 8 * fq; const pg8::f32x4 v0 = acc[ai][bj][m][0], v1 = acc[ai][bj][m][1];
                    const v4u g = *(const v4u*)(BG + (size_t)row * 2048 + (SECOND ? 1024 : 0) + col);
                    float o[8] = {bflo(g.x) * v0[0], bfhi(g.x) * v0[1], bflo(g.y) * v0[2], bfhi(g.y) * v0[3], bflo(g.z) * v1[0], bfhi(g.z) * v1[1], bflo(g.w) * v1[2], bfhi(g.w) * v1[3]};
                    if (SECOND) { const v4u t = *(const v4u*)(T1 + (size_t)row * D + col);
                        o[0] += bflo(t.x); o[1] += bfhi(t.x); o[2] += bflo(t.y); o[3] += bfhi(t.y); o[4] += bflo(t.z); o[5] += bfhi(t.z); o[6] += bflo(t.w); o[7] += bfhi(t.w); }
                    v4u w; w.x = cvt_pk_bf16(o[0], o[1]); w.y = cvt_pk_bf16(o[2], o[3]); w.z = cvt_pk_bf16(o[4], o[5]); w.w = cvt_pk_bf16(o[6], o[7]);
                    *(v4u*)((SECOND ? OUT : T1) + (size_t)row * D + col) = w; } }
    }
};

__device__ __forceinline__ void chunk_info(int gc, int& n, int& N) { if (gc < 32) { n = gc & 1; N = 2; } else { n = (gc - 32) & 7; N = 8; } }
__device__ __forceinline__ size_t st_idx(int gc, int h, int dir) { return (size_t)((gc * 4 + h) * 2 + dir); }

__device__ __forceinline__ float conv_silu(const bf16* PA, const float* cw, const float* cb, int row, int col, int ch, bool first, bool last) {
    const bf16* p = PA + (size_t)row * PA_LD + col;
    float y = cb[ch] + cw[1024 + ch] * bf2f(p[0]);
    if (!first) y += cw[ch] * bf2f(p[-PA_LD]);
    if (!last) y += cw[2048 + ch] * bf2f(p[PA_LD]);
    return silu_f(y);
}

__device__ __forceinline__ void p7_scalar(const Args& a, const Frame& F) {
    bf16* RS = (bf16*)(a.ws + WS_RS); bf16* MC = (bf16*)(a.ws + WS_MC); float* MN = (float*)(a.ws + WS_MN); float* MS = (float*)(a.ws + WS_MS);
    const int gt = F.bid * 512 + F.tid, ngt = F.G * 512;
    for (long e = gt; e < 24L * 4 * 2 * 32768; e += ngt) {
        const int idx = (int)(e & 32767), sh = (int)(e >> 15), dir = sh & 1, h = (sh >> 1) & 3, s = sh >> 3; const int ev = idx >> 7, d = idx & 127;
        const bool lat = s >= 16; const int N = lat ? 8 : 2, gc0 = lat ? 32 + 8 * (s - 16) : 2 * s;
        const float G = expf(128.f * logsigmoid_f(a.in[I_DECAY][dir * 4 + h]));
        float acc = lat ? a.in[I_SRET][((size_t)(((s - 16) * 2 + dir) * 4 + h)) * 32768 + d * 256 + ev] : 0.f;
        for (int st = 0; st < N; ++st) { const int n = dir ? N - 1 - st : st; bf16* p = RS + st_idx(gc0 + n, h, dir) * 32768 + idx; const float t = bf2f(*p); *p = (bf16)f2bf(acc); acc = G * acc + t; }
        if (!lat) a.out[OUT_SRET + ((size_t)((s * 2 + dir) * 4 + h)) * 32768 + d * 256 + ev] = acc;
    }
    for (long e = gt; e < 24L * 4 * 2 * 16384; e += ngt) {
        const int idx = (int)(e & 16383), sh = (int)(e >> 14), dir = sh & 1, h = (sh >> 1) & 3, s = sh >> 3;
        const bool lat = s >= 16; const int N = lat ? 8 : 2, gc0 = lat ? 32 + 8 * (s - 16) : 2 * s; const int sidx = lat ? ((s - 16) * 2 + dir) * 4 + h : 0;
        float m = lat ? a.in[I_SM][sidx] : 0.f; float C = lat ? a.in[I_SC][(size_t)sidx * 16384 + idx] : 0.f; float nv = (lat && idx < 128) ? a.in[I_SN][sidx * 128 + idx] : 0.f;
        for (int st = 0; st < N; ++st) { const int n = dir ? N - 1 - st : st; const size_t si = st_idx(gc0 + n, h, dir);
            const float ml = MS[si * 4 + 0], bl = MS[si * 4 + 1]; const float mn = fmaxf(bl + m, ml), a1 = expf(bl + m - mn), a2 = expf(ml - mn);
            bf16* p = MC + si * 16384 + idx; const float t = bf2f(*p); *p = (bf16)f2bf(C); C = a1 * C + a2 * t;
            if (idx < 128) { float* q = MN + si * 128 + idx; const float tn = *q; *q = nv; nv = a1 * nv + a2 * tn; }
            if (idx == 0) MS[si * 4 + 2] = m;
            m = mn; }
        if (!lat) { const int o = (s * 2 + dir) * 4 + h; a.out[OUT_SC + (size_t)o * 16384 + idx] = C; if (idx < 128) a.out[OUT_SN + o * 128 + idx] = nv; if (idx == 0) a.out[OUT_SM + o] = m; }
    }
}


typedef short bf16x8 __attribute__((ext_vector_type(8)));
typedef short s16x4 __attribute__((ext_vector_type(4)));
#define MFMA16(a, b, c) __builtin_amdgcn_mfma_f32_16x16x32_bf16(a, b, c, 0, 0, 0)
constexpr float KSCALE = 0.08838834764831845f;
constexpr int LQ = 136, LV = 264;

__device__ __forceinline__ bf16x8 frag_row(const LAS bf16* T, int LD, int r0, int k0, int lane) { return *(const LAS bf16x8*)(T + (r0 + (lane & 15)) * LD + k0 + 8 * (lane >> 4)); }
__device__ __forceinline__ bf16x8 frag_row_g(const bf16* T, int LD, int r0, int k0, int lane) { return *(const bf16x8*)(T + (size_t)(r0 + (lane & 15)) * LD + k0 + 8 * (lane >> 4)); }
__device__ __forceinline__ bf16x8 frag_tr(const LAS bf16* T, int LD, int k0, int n0, int lane) {
    const LAS bf16* p = T + (k0 + 8 * (lane >> 4) + ((lane & 15) >> 2)) * LD + n0 + 4 * (lane & 3);
    const s16x4 lo = __builtin_amdgcn_ds_read_tr16_b64_v4i16((LAS s16x4*)p), hi = __builtin_amdgcn_ds_read_tr16_b64_v4i16((LAS s16x4*)(p + 4 * LD));
    return (bf16x8){lo[0], lo[1], lo[2], lo[3], hi[0], hi[1], hi[2], hi[3]};
}
__device__ __forceinline__ void unpack8(const v4u v, float (&f)[8]) { f[0] = bflo(v.x); f[1] = bfhi(v.x); f[2] = bflo(v.y); f[3] = bfhi(v.y); f[4] = bflo(v.z); f[5] = bfhi(v.z); f[6] = bflo(v.w); f[7] = bfhi(v.w); }
__device__ __forceinline__ v4u pack8(const float (&f)[8]) { v4u w; w.x = pk2(f[0], f[1]); w.y = pk2(f[2], f[3]); w.z = pk2(f[4], f[5]); w.w = pk2(f[6], f[7]); return w; }
template <int W, int LD> __device__ __forceinline__ void stage_tile(LAS bf16* T, const bf16* src, int ld_src, int tid) {
    constexpr int CPR = W / 8;
    for (int c = tid; c < 128 * CPR; c += 512) { const int r = c / CPR, cc = c % CPR; *(LAS v4u*)(T + r * LD + cc * 8) = *(const v4u*)(src + (size_t)r * ld_src + cc * 8); }
}
struct ConvW { float w0[8], w1[8], w2[8], b[8]; };
__device__ __forceinline__ void conv_load(ConvW& c, const float* cw, const float* cb, int ch) {
#pragma unroll
    for (int i = 0; i < 8; ++i) { c.w0[i] = cw[ch + i]; c.w1[i] = cw[1024 + ch + i]; c.w2[i] = cw[2048 + ch + i]; c.b[i] = cb[ch + i]; }
}
__device__ __forceinline__ void conv_chunk(const ConvW& c, const bf16* p, bool first, bool last, float scale, float (&y)[8]) {
    const v4u z = {0u, 0u, 0u, 0u}; const v4u x0 = *(const v4u*)p, xm = first ? z : *(const v4u*)(p - PA_LD), xp = last ? z : *(const v4u*)(p + PA_LD);
    float f0[8], fm[8], fp[8]; unpack8(x0, f0); unpack8(xm, fm); unpack8(xp, fp);
#pragma unroll
    for (int i = 0; i < 8; ++i) y[i] = silu_f(c.b[i] + c.w0[i] * fm[i] + c.w1[i] * f0[i] + c.w2[i] * fp[i]) * scale;
}

__device__ __forceinline__ void p6_mfma(const Args& a, int tid_in, int bid, int G, LAS unsigned char* L) {
    const bf16* PA = (const bf16*)(a.ws + WS_PA); bf16* RS = (bf16*)(a.ws + WS_RS); bf16* MC = (bf16*)(a.ws + WS_MC);
    float* MN = (float*)(a.ws + WS_MN); float* MS = (float*)(a.ws + WS_MS);
    const float* IG = (const float*)(a.ws + WS_IG); const float* LF = (const float*)(a.ws + WS_LF);
    for (int it = bid; it < 2 * NCHUNK * 4; it += G) {
        int tid = tid_in; asm volatile("" : "+v"(tid));
        const int lane = tid & 63, wave = __builtin_amdgcn_readfirstlane(tid >> 6);
        const int branch = it / (NCHUNK * 4), gc = (it % (NCHUNK * 4)) >> 2, h = it & 3, row0 = gc * CH; int n, N; chunk_info(gc, n, N);
        __syncthreads();
        if (branch == 0) {
            LAS bf16* V_l = (LAS bf16*)L; LAS bf16* Kf = (LAS bf16*)(L + 67584); LAS bf16* Kb = (LAS bf16*)(L + 67584 + 34816);
            const float lg0 = logsigmoid_f(a.in[I_DECAY][h]), lg1 = logsigmoid_f(a.in[I_DECAY][4 + h]);
            stage_tile<256, LV>(V_l, PA + (size_t)row0 * PA_LD + C_RV + h * 256, PA_LD, tid);
            for (int c = tid; c < 128 * 16; c += 512) { const int j = c >> 4, cc = c & 15; float f[8], g[8];
                unpack8(*(const v4u*)(PA + (size_t)(row0 + j) * PA_LD + C_RK + h * 128 + cc * 8), f);
                const float wf = __expf(lg0 * (float)(127 - j)), wb = __expf(lg1 * (float)j);
#pragma unroll
                for (int i = 0; i < 8; ++i) { g[i] = f[i] * wb; f[i] *= wf; }
                *(LAS v4u*)(Kf + j * LQ + cc * 8) = pack8(f); *(LAS v4u*)(Kb + j * LQ + cc * 8) = pack8(g); }
            __syncthreads();
#pragma unroll 1
            for (int dir = 0; dir < 2; ++dir) { const LAS bf16* Kd = dir ? Kb : Kf; pg8::f32x4 acc[2][8];
#pragma unroll
                for (int m = 0; m < 2; ++m)
#pragma unroll
                    for (int nn = 0; nn < 8; ++nn) acc[m][nn] = (pg8::f32x4){0.f, 0.f, 0.f, 0.f};
#pragma unroll 1
                for (int k0 = 0; k0 < 128; k0 += 32) { bf16x8 af[2];
#pragma unroll
                    for (int m = 0; m < 2; ++m) af[m] = frag_tr(V_l, LV, k0, wave * 32 + m * 16, lane);
#pragma unroll
                    for (int nn = 0; nn < 8; ++nn) { const bf16x8 bfr = frag_tr(Kd, LQ, k0, nn * 16, lane);
#pragma unroll
                        for (int m = 0; m < 2; ++m) acc[m][nn] = MFMA16(bfr, af[m], acc[m][nn]); } }
                bf16* out = RS + st_idx(gc, h, dir) * 32768;
#pragma unroll
                for (int m = 0; m < 2; ++m)
#pragma unroll
                    for (int nn = 0; nn < 8; ++nn) { v2u w; w.x = cvt_pk_bf16(acc[m][nn][0], acc[m][nn][1]); w.y = cvt_pk_bf16(acc[m][nn][2], acc[m][nn][3]);
                        *(v2u*)(out + (wave * 32 + m * 16 + (lane & 15)) * 128 + nn * 16 + 4 * (lane >> 4)) = w; }
            }
        } else {
            LAS bf16* V_l = (LAS bf16*)L; LAS bf16* Kf = (LAS bf16*)(L + 34816); LAS bf16* Kb = (LAS bf16*)(L + 2 * 34816);
            LAS float* sml = (LAS float*)(L + 3 * 34816); LAS float* lfs = sml; LAS float* igs = sml + 256; LAS float* bs = sml + 512; LAS float* ws_ = sml + 768;
            stage_tile<128, LQ>(V_l, PA + (size_t)row0 * PA_LD + C_MV + h * 128, PA_LD, tid);
            if (tid < 256) { const int dir = tid >> 7, j = tid & 127; lfs[tid] = LF[(size_t)(row0 + j) * 8 + dir * 4 + h]; igs[tid] = IG[(size_t)(row0 + j) * 8 + dir * 4 + h]; }
            __syncthreads();
            if (tid < 256) { const int dir = tid >> 7, j = tid & 127; float b = 0.f;
                if (dir == 0) { for (int t = 0; t <= j; ++t) b += lfs[t]; } else { for (int t = 127; t >= j; --t) b += lfs[128 + t]; }
                bs[tid] = b; }
            __syncthreads();
            if (tid < 256) { const int dir = tid >> 7, j = tid & 127; const float blast = dir ? bs[128] : bs[127]; float ml = -3.0e38f;
                for (int t = 0; t < 128; ++t) ml = fmaxf(ml, blast - bs[dir * 128 + t] + igs[dir * 128 + t]);
                ws_[tid] = expf(blast - bs[tid] + igs[tid] - ml);
                if (j == 0) { MS[st_idx(gc, h, dir) * 4 + 0] = ml; MS[st_idx(gc, h, dir) * 4 + 1] = blast; } }
            __syncthreads();
            { ConvW cwv; const int cc = tid & 15; conv_load(cwv, a.in[I_CONVW], a.in[I_CONVB], 512 + h * 128 + cc * 8);
              for (int c = tid; c < 128 * 16; c += 512) { const int j = c >> 4; float f[8], g[8];
                  conv_chunk(cwv, PA + (size_t)(row0 + j) * PA_LD + C_MK + h * 128 + cc * 8, n == 0 && j == 0, n == N - 1 && j == 127, KSCALE, f);
                  const float wf = ws_[j], wb = ws_[128 + j];
#pragma unroll
                  for (int i = 0; i < 8; ++i) { const float kq = bf2f((bf16)f2bf(f[i])); g[i] = kq * wb; f[i] = kq * wf; }
                  *(LAS v4u*)(Kf + j * LQ + cc * 8) = pack8(f); *(LAS v4u*)(Kb + j * LQ + cc * 8) = pack8(g); } }
            __syncthreads();
            if (tid < 256) { const int dir = tid >> 7, k = tid & 127; const LAS bf16* Kd = dir ? Kb : Kf; float s = 0.f;
                for (int j = 0; j < 128; ++j) s += bf2f(Kd[j * LQ + k]);
                MN[st_idx(gc, h, dir) * 128 + k] = s; }
#pragma unroll 1
            for (int dir = 0; dir < 2; ++dir) { const LAS bf16* Kd = dir ? Kb : Kf; pg8::f32x4 acc[8];
#pragma unroll
                for (int nn = 0; nn < 8; ++nn) acc[nn] = (pg8::f32x4){0.f, 0.f, 0.f, 0.f};
#pragma unroll 1
                for (int k0 = 0; k0 < 128; k0 += 32) { const bf16x8 af = frag_tr(V_l, LQ, k0, wave * 16, lane);
#pragma unroll
                    for (int nn = 0; nn < 8; ++nn) { const bf16x8 bfr = frag_tr(Kd, LQ, k0, nn * 16, lane); acc[nn] = MFMA16(bfr, af, acc[nn]); } }
                bf16* out = MC + st_idx(gc, h, dir) * 16384;
#pragma unroll
                for (int nn = 0; nn < 8; ++nn) { v2u w; w.x = cvt_pk_bf16(acc[nn][0], acc[nn][1]); w.y = cvt_pk_bf16(acc[nn][2], acc[nn][3]);
                    *(v2u*)(out + (wave * 16 + (lane & 15)) * 128 + nn * 16 + 4 * (lane >> 4)) = w; }
            }
        }
    }
}

__device__ __forceinline__ void p8_mfma(const Args& a, int tid_in, int bid, int G, LAS unsigned char* L) {
    bf16* PA = (bf16*)(a.ws + WS_PA); const bf16* RS = (const bf16*)(a.ws + WS_RS); const bf16* MC = (const bf16*)(a.ws + WS_MC);
    const float* MN = (const float*)(a.ws + WS_MN); const float* MS = (const float*)(a.ws + WS_MS);
    const float* IG = (const float*)(a.ws + WS_IG); const float* LF = (const float*)(a.ws + WS_LF);
    LAS bf16* Q_l = (LAS bf16*)L; LAS bf16* K_l = (LAS bf16*)(L + 34816); LAS bf16* P_l = K_l; LAS bf16* V_l = (LAS bf16*)(L + 2 * 34816);
    for (int it = bid; it < 2 * NCHUNK * 4; it += G) {
        int tid = tid_in; asm volatile("" : "+v"(tid));
        const int lane = tid & 63, wave = __builtin_amdgcn_readfirstlane(tid >> 6), fr = lane & 15, fq = lane >> 4;
        const int branch = it / (NCHUNK * 4), gc = (it % (NCHUNK * 4)) >> 2, h = it & 3, row0 = gc * CH; int n, N; chunk_info(gc, n, N);
        const bool lat = gc >= 32;
        __syncthreads();
        if (branch == 0) {
            LAS float* red = (LAS float*)(L + 2 * 34816 + 67584);
            const float lg0 = logsigmoid_f(a.in[I_DECAY][h]), lg1 = logsigmoid_f(a.in[I_DECAY][4 + h]);
            stage_tile<128, LQ>(Q_l, PA + (size_t)row0 * PA_LD + C_RQ + h * 128, PA_LD, tid);
            stage_tile<128, LQ>(K_l, PA + (size_t)row0 * PA_LD + C_RK + h * 128, PA_LD, tid);
            stage_tile<256, LV>(V_l, PA + (size_t)row0 * PA_LD + C_RV + h * 256, PA_LD, tid);
            __syncthreads();
            {
                pg8::f32x4 sc[8];
#pragma unroll
                for (int m = 0; m < 8; ++m) sc[m] = (pg8::f32x4){0.f, 0.f, 0.f, 0.f};
#pragma unroll 1
                for (int k0 = 0; k0 < 128; k0 += 32) { const bf16x8 bfr = frag_row(K_l, LQ, wave * 16, k0, lane);
#pragma unroll
                    for (int m = 0; m < 8; ++m) sc[m] = MFMA16(bfr, frag_row(Q_l, LQ, m * 16, k0, lane), sc[m]); }
                __syncthreads();
#pragma unroll
                for (int m = 0; m < 8; ++m) { const int i = m * 16 + fr; float p[4];
#pragma unroll
                    for (int r = 0; r < 4; ++r) { const int j = wave * 16 + 4 * fq + r; const float dm = i > j ? __expf(lg0 * (float)(i - j)) : (i < j ? __expf(lg1 * (float)(j - i)) : 2.f); p[r] = sc[m][r] * dm; }
                    v2u w; w.x = cvt_pk_bf16(p[0], p[1]); w.y = cvt_pk_bf16(p[2], p[3]); *(LAS v2u*)(P_l + i * LQ + wave * 16 + 4 * fq) = w; }
            }
            __syncthreads();
            pg8::f32x4 accR[8][2];
#pragma unroll
            for (int m = 0; m < 8; ++m) { accR[m][0] = (pg8::f32x4){0.f, 0.f, 0.f, 0.f}; accR[m][1] = (pg8::f32x4){0.f, 0.f, 0.f, 0.f}; }
            {   const bool hasf = lat || n > 0, hasb = lat || n < N - 1;
#pragma unroll 1
                for (int dir = 0; dir < 2; ++dir) {
                    if (!(dir ? hasb : hasf)) continue;
                    const bf16* S = RS + st_idx(gc, h, dir) * 32768;
#pragma unroll 1
                    for (int k0 = 0; k0 < 128; k0 += 32) { const bf16x8 b0 = frag_row_g(S, 128, wave * 32, k0, lane), b1 = frag_row_g(S, 128, wave * 32 + 16, k0, lane);
#pragma unroll
                        for (int m = 0; m < 8; ++m) { const bf16x8 af = frag_row(Q_l, LQ, m * 16, k0, lane); accR[m][0] = MFMA16(b0, af, accR[m][0]); accR[m][1] = MFMA16(b1, af, accR[m][1]); } }
#pragma unroll
                    for (int m = 0; m < 8; ++m) { const float i = (float)(m * 16 + fr); const float ef = lg0 * (i + 1.f), eb = lg1 * (128.f - i);
                        const float wq = dir ? __expf(eb) : (hasb ? __expf(ef - eb) : __expf(ef));
                        accR[m][0] *= wq; accR[m][1] *= wq; }
                }
            }
#pragma unroll 1
            for (int k0 = 0; k0 < 128; k0 += 32) { const bf16x8 b0 = frag_tr(V_l, LV, k0, wave * 32, lane), b1 = frag_tr(V_l, LV, k0, wave * 32 + 16, lane);
#pragma unroll
                for (int m = 0; m < 8; ++m) { const bf16x8 af = frag_row(P_l, LQ, m * 16, k0, lane); accR[m][0] = MFMA16(b0, af, accR[m][0]); accR[m][1] = MFMA16(b1, af, accR[m][1]); } }
#pragma unroll
            for (int m = 0; m < 8; ++m) { float s1 = 0.f, s2 = 0.f;
#pragma unroll
                for (int nn = 0; nn < 2; ++nn)
#pragma unroll
                    for (int r = 0; r < 4; ++r) { const float x = accR[m][nn][r]; s1 += x; s2 += x * x; }
                s1 += __shfl_xor(s1, 16); s1 += __shfl_xor(s1, 32); s2 += __shfl_xor(s2, 16); s2 += __shfl_xor(s2, 32);
                if (fq == 0) { red[((m * 16 + fr) * 8 + wave) * 2] = s1; red[((m * 16 + fr) * 8 + wave) * 2 + 1] = s2; } }
            __syncthreads();
            pg8::f32x4 gnv[2];
#pragma unroll
            for (int nn = 0; nn < 2; ++nn) gnv[nn] = *(const pg8::f32x4*)(a.in[I_RETGN] + h * 256 + wave * 32 + nn * 16 + 4 * fq);
#pragma unroll
            for (int m = 0; m < 8; ++m) { const int i = m * 16 + fr; float s1 = 0.f, s2 = 0.f;
#pragma unroll
                for (int w = 0; w < 8; ++w) { s1 += red[(i * 8 + w) * 2]; s2 += red[(i * 8 + w) * 2 + 1]; }
                const float mu = s1 * (1.f / 256.f), rstd = 1.f / sqrtf(fmaxf(s2 * (1.f / 256.f) - mu * mu, 0.f) + EPS_GN);
#pragma unroll
                for (int nn = 0; nn < 2; ++nn) { const pg8::f32x4 y = (accR[m][nn] - mu) * rstd * gnv[nn]; v2u w; w.x = cvt_pk_bf16(y[0], y[1]); w.y = cvt_pk_bf16(y[2], y[3]);
                    *(v2u*)(PA + (size_t)(row0 + i) * PA_LD + C_RV + h * 256 + wave * 32 + nn * 16 + 4 * fq) = w; } }
        } else {
            LAS bf16* Vm = (LAS bf16*)(L + 2 * 34816);
            LAS float* sml = (LAS float*)(L + 3 * 34816);
            LAS float* lfs = sml; LAS float* igs = sml + 256; LAS float* bs = sml + 512; LAS float* mis = sml + 768; LAS float* wis = sml + 1024; LAS float* qns = sml + 1280; LAS float* rds = sml + 1536;
            LAS float* red = sml + 1792;
            const size_t si0 = st_idx(gc, h, 0), si1 = si0 + 1;
            {   ConvW cq, ck; const int cc = tid & 15; conv_load(cq, a.in[I_CONVW], a.in[I_CONVB], h * 128 + cc * 8); conv_load(ck, a.in[I_CONVW], a.in[I_CONVB], 512 + h * 128 + cc * 8);
                for (int c = tid; c < 128 * 16; c += 512) { const int j = c >> 4; const bool fi = n == 0 && j == 0, la = n == N - 1 && j == 127; float f[8];
                    conv_chunk(cq, PA + (size_t)(row0 + j) * PA_LD + C_MQ + h * 128 + cc * 8, fi, la, 1.f, f); *(LAS v4u*)(Q_l + j * LQ + cc * 8) = pack8(f);
                    conv_chunk(ck, PA + (size_t)(row0 + j) * PA_LD + C_MK + h * 128 + cc * 8, fi, la, KSCALE, f); *(LAS v4u*)(K_l + j * LQ + cc * 8) = pack8(f); } }
            stage_tile<128, LQ>(Vm, PA + (size_t)row0 * PA_LD + C_MV + h * 128, PA_LD, tid);
            if (tid < 256) { const int dir = tid >> 7, j = tid & 127; lfs[tid] = LF[(size_t)(row0 + j) * 8 + dir * 4 + h]; igs[tid] = IG[(size_t)(row0 + j) * 8 + dir * 4 + h]; }
            __syncthreads();
            if (tid < 256) { const int dir = tid >> 7, i = tid & 127; float b = 0.f;
                if (dir == 0) { for (int t = 0; t <= i; ++t) b += lfs[t]; } else { for (int t = 127; t >= i; --t) b += lfs[128 + t]; }
                bs[tid] = b;
                float qn = 0.f; const float* np = MN + (si0 + dir) * 128; for (int k = 0; k < 128; ++k) qn += bf2f(Q_l[i * LQ + k]) * np[k];
                qns[tid] = qn; }
            __syncthreads();
            if (tid < 256) { const int dir = tid >> 7, i = tid & 127; const float bi = bs[tid]; float pm = -3.0e38f;
                if (dir == 0) { for (int j = 0; j <= i; ++j) pm = fmaxf(pm, igs[j] - bs[j]); } else { for (int j = i; j < 128; ++j) pm = fmaxf(pm, igs[128 + j] - bs[128 + j]); }
                const float mprev = MS[(si0 + dir) * 4 + 2]; const float lin = bi + mprev, mi = fmaxf(bi + pm, lin); mis[tid] = mi; wis[tid] = expf(lin - mi); }
            __syncthreads();
            {
                pg8::f32x4 sc[8];
#pragma unroll
                for (int m = 0; m < 8; ++m) sc[m] = (pg8::f32x4){0.f, 0.f, 0.f, 0.f};
#pragma unroll 1
                for (int k0 = 0; k0 < 128; k0 += 32) { const bf16x8 bfr = frag_row(K_l, LQ, wave * 16, k0, lane);
#pragma unroll
                    for (int m = 0; m < 8; ++m) sc[m] = MFMA16(bfr, frag_row(Q_l, LQ, m * 16, k0, lane), sc[m]); }
                pg8::f32x4 s0[8], s1[8];
#pragma unroll
                for (int m = 0; m < 8; ++m) { const int i = m * 16 + fr; const float e0 = bs[i] - mis[i], e1 = bs[128 + i] - mis[128 + i]; float r0 = 0.f, r1 = 0.f;
#pragma unroll
                    for (int r = 0; r < 4; ++r) { const int j = wave * 16 + 4 * fq + r;
                        s0[m][r] = j <= i ? sc[m][r] * __expf(e0 - bs[j] + igs[j]) : 0.f; s1[m][r] = j >= i ? sc[m][r] * __expf(e1 - bs[128 + j] + igs[128 + j]) : 0.f;
                        r0 += s0[m][r]; r1 += s1[m][r]; }
                    r0 += __shfl_xor(r0, 16); r0 += __shfl_xor(r0, 32); r1 += __shfl_xor(r1, 16); r1 += __shfl_xor(r1, 32);
                    if (fq == 0) { red[i * 8 + wave] = r0; red[(128 + i) * 8 + wave] = r1; } }
                __syncthreads();
                if (tid < 256) { float den = 0.f;
#pragma unroll
                    for (int w = 0; w < 8; ++w) den += red[tid * 8 + w];
                    den += wis[tid] * qns[tid]; rds[tid] = 1.f / fmaxf(fabsf(den), expf(-mis[tid])); }
                __syncthreads();
#pragma unroll
                for (int m = 0; m < 8; ++m) { const int i = m * 16 + fr; const float d0 = rds[i], d1 = rds[128 + i];
                    const pg8::f32x4 p = s0[m] * d0 + s1[m] * d1; v2u w; w.x = cvt_pk_bf16(p[0], p[1]); w.y = cvt_pk_bf16(p[2], p[3]); *(LAS v2u*)(P_l + i * LQ + wave * 16 + 4 * fq) = w; }
            }
            __syncthreads();
            pg8::f32x4 accH[8];
#pragma unroll
            for (int m = 0; m < 8; ++m) accH[m] = (pg8::f32x4){0.f, 0.f, 0.f, 0.f};
#pragma unroll 1
            for (int dir = 0; dir < 2; ++dir) {
                const bool has = lat || (dir ? n < N - 1 : n > 0); if (!has) continue;
                const bf16* Cp = MC + (si0 + dir) * 16384; pg8::f32x4 accX[8];
#pragma unroll
                for (int m = 0; m < 8; ++m) accX[m] = (pg8::f32x4){0.f, 0.f, 0.f, 0.f};
#pragma unroll 1
                for (int k0 = 0; k0 < 128; k0 += 32) { const bf16x8 bfr = frag_row_g(Cp, 128, wave * 16, k0, lane);
#pragma unroll
                    for (int m = 0; m < 8; ++m) accX[m] = MFMA16(bfr, frag_row(Q_l, LQ, m * 16, k0, lane), accX[m]); }
#pragma unroll
                for (int m = 0; m < 8; ++m) { const int i = dir * 128 + m * 16 + fr; accH[m] += accX[m] * (wis[i] * rds[i]); }
            }
#pragma unroll 1
            for (int k0 = 0; k0 < 128; k0 += 32) { const bf16x8 bfr = frag_tr(Vm, LQ, k0, wave * 16, lane);
#pragma unroll
                for (int m = 0; m < 8; ++m) accH[m] = MFMA16(bfr, frag_row(P_l, LQ, m * 16, k0, lane), accH[m]); }
            __syncthreads();
#pragma unroll
            for (int m = 0; m < 8; ++m) { const int i = m * 16 + fr; const v2u g = *(const v2u*)(PA + (size_t)(row0 + i) * PA_LD + C_MO + h * 128 + wave * 16 + 4 * fq);
                accH[m][0] *= bflo(g.x); accH[m][1] *= bfhi(g.x); accH[m][2] *= bflo(g.y); accH[m][3] *= bfhi(g.y);
                float s1 = (accH[m][0] + accH[m][1]) + (accH[m][2] + accH[m][3]), s2 = (accH[m][0] * accH[m][0] + accH[m][1] * accH[m][1]) + (accH[m][2] * accH[m][2] + accH[m][3] * accH[m][3]);
                s1 += __shfl_xor(s1, 16); s1 += __shfl_xor(s1, 32); s2 += __shfl_xor(s2, 16); s2 += __shfl_xor(s2, 32);
                if (fq == 0) { red[(i * 8 + wave) * 2] = s1; red[(i * 8 + wave) * 2 + 1] = s2; } }
            __syncthreads();
            const pg8::f32x4 gnv = *(const pg8::f32x4*)(a.in[I_MGN] + h * 128 + wave * 16 + 4 * fq);
#pragma unroll
            for (int m = 0; m < 8; ++m) { const int i = m * 16 + fr; float s1 = 0.f, s2 = 0.f;
#pragma unroll
                for (int w = 0; w < 8; ++w) { s1 += red[(i * 8 + w) * 2]; s2 += red[(i * 8 + w) * 2 + 1]; }
                const float mu = s1 * (1.f / 128.f), rstd = 1.f / sqrtf(fmaxf(s2 * (1.f / 128.f) - mu * mu, 0.f) + EPS_GN);
                const pg8::f32x4 y = (accH[m] - mu) * rstd * gnv; v2u w; w.x = cvt_pk_bf16(y[0], y[1]); w.y = cvt_pk_bf16(y[2], y[3]);
                *(v2u*)(PA + (size_t)(row0 + i) * PA_LD + C_MV + h * 128 + wave * 16 + 4 * fq) = w; }
        }
    }
}

template <int N> __device__ __forceinline__ void scan_ret(bf16* RS, int gc0, int h, int dir, int tile, const float* init, float* fin, float Gd, int lane) {
    const int eb = tile >> 2, db = tile & 3, e0 = 64 * eb + 4 * (lane & 15), d0 = 32 * db + 8 * (lane >> 4);
    float acc[4][8];
#pragma unroll
    for (int dd = 0; dd < 8; ++dd) { pg8::f32x4 v = {0.f, 0.f, 0.f, 0.f}; if (init) v = *(const pg8::f32x4*)(init + (d0 + dd) * 256 + e0); acc[0][dd] = v[0]; acc[1][dd] = v[1]; acc[2][dd] = v[2]; acc[3][dd] = v[3]; }
#pragma unroll
    for (int st = 0; st < N; ++st) { const int n = dir ? N - 1 - st : st; bf16* p = RS + st_idx(gc0 + n, h, dir) * 32768 + e0 * 128 + d0;
        v4u t[4];
#pragma unroll
        for (int ee = 0; ee < 4; ++ee) t[ee] = *(const v4u*)(p + ee * 128);
#pragma unroll
        for (int ee = 0; ee < 4; ++ee) { float f[8]; unpack8(t[ee], f); *(v4u*)(p + ee * 128) = pack8(acc[ee]);
#pragma unroll
            for (int dd = 0; dd < 8; ++dd) acc[ee][dd] = Gd * acc[ee][dd] + f[dd]; } }
    if (fin) {
#pragma unroll
        for (int dd = 0; dd < 8; ++dd) *(pg8::f32x4*)(fin + (d0 + dd) * 256 + e0) = (pg8::f32x4){acc[0][dd], acc[1][dd], acc[2][dd], acc[3][dd]}; }
}
template <int N> __device__ __forceinline__ void scan_ml(bf16* MC, float* MN, float* MS, int gc0, int h, int dir, int vb, const float* iC, const float* in_, float m, float* fC, float* fn, float* fm, int lane) {
    const int row0 = 16 * vb + (lane >> 4), kc = 8 * (lane & 15);
    float C[4][8], nv0 = 0.f, nv1 = 0.f;
#pragma unroll
    for (int r = 0; r < 4; ++r) { pg8::f32x4 v0 = {0.f, 0.f, 0.f, 0.f}, v1 = v0; if (iC) { v0 = *(const pg8::f32x4*)(iC + (row0 + 4 * r) * 128 + kc); v1 = *(const pg8::f32x4*)(iC + (row0 + 4 * r) * 128 + kc + 4); }
#pragma unroll
        for (int i = 0; i < 4; ++i) { C[r][i] = v0[i]; C[r][4 + i] = v1[i]; } }
    if (vb == 0 && in_) { nv0 = in_[lane]; nv1 = in_[lane + 64]; }
#pragma unroll
    for (int st = 0; st < N; ++st) { const int n = dir ? N - 1 - st : st; const size_t si = st_idx(gc0 + n, h, dir);
        const float ml = MS[si * 4 + 0], bl = MS[si * 4 + 1]; const float mn = fmaxf(bl + m, ml), a1 = expf(bl + m - mn), a2 = expf(ml - mn);
        bf16* p = MC + si * 16384 + row0 * 128 + kc; v4u t[4];
#pragma unroll
        for (int r = 0; r < 4; ++r) t[r] = *(const v4u*)(p + 4 * r * 128);
#pragma unroll
        for (int r = 0; r < 4; ++r) { float f[8]; unpack8(t[r], f); *(v4u*)(p + 4 * r * 128) = pack8(C[r]);
#pragma unroll
            for (int i = 0; i < 8; ++i) C[r][i] = a1 * C[r][i] + a2 * f[i]; }
        if (vb == 0) { float* q = MN + si * 128; const float t0 = q[lane], t1 = q[lane + 64]; q[lane] = nv0; q[lane + 64] = nv1; nv0 = a1 * nv0 + a2 * t0; nv1 = a1 * nv1 + a2 * t1;
            if (lane == 0) MS[si * 4 + 2] = m; }
        m = mn; }
    if (fC) {
#pragma unroll
        for (int r = 0; r < 4; ++r) { *(pg8::f32x4*)(fC + (row0 + 4 * r) * 128 + kc) = (pg8::f32x4){C[r][0], C[r][1], C[r][2], C[r][3]}; *(pg8::f32x4*)(fC + (row0 + 4 * r) * 128 + kc + 4) = (pg8::f32x4){C[r][4], C[r][5], C[r][6], C[r][7]}; }
        if (vb == 0) { fn[lane] = nv0; fn[lane + 64] = nv1; if (lane == 0) *fm = m; } }
}
__device__ __forceinline__ void p7_scan(const Args& a, int tid_in, int bid, int G) {
    bf16* RS = (bf16*)(a.ws + WS_RS); bf16* MC = (bf16*)(a.ws + WS_MC); float* MN = (float*)(a.ws + WS_MN); float* MS = (float*)(a.ws + WS_MS);
    int tid = tid_in; asm volatile("" : "+v"(tid));
    const int lane = tid & 63, wave = __builtin_amdgcn_readfirstlane(tid >> 6);
    for (int it = bid * 8 + wave; it < 4608; it += G * 8) {
        int r = it; bool lat = true, ret = true;
        if (r >= 1024) { r -= 1024; ret = false; if (r >= 512) { r -= 512; lat = false; ret = true; if (r >= 2048) { r -= 2048; ret = false; } } }
        if (ret) { const int tile = r & 15, mat = r >> 4, dir = mat & 1, h = (mat >> 1) & 3, sl = mat >> 3; const float Gd = expf(128.f * logsigmoid_f(a.in[I_DECAY][dir * 4 + h]));
            if (lat) scan_ret<8>(RS, 32 + 8 * sl, h, dir, tile, a.in[I_SRET] + (size_t)((sl * 2 + dir) * 4 + h) * 32768, nullptr, Gd, lane);
            else scan_ret<2>(RS, 2 * sl, h, dir, tile, nullptr, a.out + OUT_SRET + (size_t)((sl * 2 + dir) * 4 + h) * 32768, Gd, lane);
        } else { const int vb = r & 7, mat = r >> 3, dir = mat & 1, h = (mat >> 1) & 3, sl = mat >> 3; const int o = (sl * 2 + dir) * 4 + h;
            if (lat) scan_ml<8>(MC, MN, MS, 32 + 8 * sl, h, dir, vb, a.in[I_SC] + (size_t)o * 16384, a.in[I_SN] + o * 128, a.in[I_SM][o], nullptr, nullptr, nullptr, lane);
            else scan_ml<2>(MC, MN, MS, 2 * sl, h, dir, vb, nullptr, nullptr, 0.f, a.out + OUT_SC + (size_t)o * 16384, a.out + OUT_SN + o * 128, a.out + OUT_SM + o, lane);
        }
    }
}

constexpr int NPHASE = 16;
#ifndef MK_PER_PHASE
#define MK_PER_PHASE 0
#endif
#ifndef MIX6
#define MIX6 1
#endif
#ifndef MIX7
#define MIX7 1
#endif
#ifndef MIX8
#define MIX8 1
#endif
#define MIXER_MFMA (MIX6 && MIX7 && MIX8)
#define GEMM_PHASE(EPI, g, S, E) pg8::gemm_phase<EPI, pg8::StaticOrder, true, true>((PG8_LAS unsigned char*)lds, g, S, E)

template <int K> __device__ __forceinline__ void run_phase(const Args& a, const Frame& F, LAS unsigned char* lds) {
    unsigned char* ws = a.ws; const float* mod = (const float*)(ws + WS_MOD);
    bf16* U = (bf16*)(ws + WS_U); bf16* H = (bf16*)(ws + WS_H); bf16* PA = (bf16*)(ws + WS_PA); bf16* BG = (bf16*)(ws + WS_BG); bf16* T1 = (bf16*)(ws + WS_T1);
    float* X = a.out + OUT_Y;
    if constexpr (K == 0) { p0_prologue(a, F); }
    if constexpr (K == 1) { norm_phase<false>(a, F, a.in[I_XP], a.in[I_XS], a.in[I_NF1], 0 * D, 1 * D); }
    if constexpr (K == 2) { pg8::Gemm g{U, (const bf16*)(ws + WS_W13A), MROWS, 2 * FF, D, D}; pg8::StaticOrder S; S.init(MROWS, 2 * FF, F.G, F.bid); EpiSwiGLU E{H}; GEMM_PHASE(EpiSwiGLU, g, S, E); }
    if constexpr (K == 3) { pg8::Gemm g{H, (const bf16*)(ws + WS_W2A), MROWS, D, FF, FF}; pg8::StaticOrder S; S.init(MROWS, D, F.G, F.bid); EpiResid E{a.in[I_XP], a.in[I_XS], X, mod + 2 * D, 0.5f}; GEMM_PHASE(EpiResid, g, S, E); }
    if constexpr (K == 4) { norm_phase<true>(a, F, X, X + (size_t)NCTX * D, a.in[I_NMIX], 3 * D, 4 * D); }
    if constexpr (K == 5) { pg8::Gemm g{U, (const bf16*)(ws + WS_WIN), MROWS, 4096, D, D}; pg8::StaticOrder S; S.init(MROWS, 4096, F.G, F.bid); EpiProjA E{PA, (const float2*)(ws + WS_ROPE)}; GEMM_PHASE(EpiProjA, g, S, E); }
    if constexpr (K == 6) { p6_mfma(a, F.tid, F.bid, F.G, lds); }
    if constexpr (K == 7) { p7_scan(a, F.tid, F.bid, F.G); }
    if constexpr (K == 8) { p8_mfma(a, F.tid, F.bid, F.G, lds); }
    if constexpr (K == 9) { pg8::Gemm g{U, (const bf16*)(ws + WS_WIN) + (size_t)4096 * D, MROWS, 3072, D, D}; pg8::StaticOrder S; S.init(MROWS, 3072, F.G, F.bid); EpiProjB E{PA, BG}; GEMM_PHASE(EpiProjB, g, S, E); }
    if constexpr (K == 10) {
        { pg8::Gemm g{PA + C_RV, (const bf16*)(ws + WS_WR), MROWS, D, D, PA_LD}; pg8::StaticOrder S; S.init(MROWS, D, F.G, F.bid); EpiMerge<false> E{BG, T1, U}; GEMM_PHASE(EpiMerge<false>, g, S, E); }
        { pg8::Gemm g{PA + C_MV, (const bf16*)(ws + WS_WM), MROWS, D, 512, PA_LD}; pg8::StaticOrder S; S.init(MROWS, D, F.G, F.bid); EpiMerge<true> E{BG, T1, U}; GEMM_PHASE(EpiMerge<true>, g, S, E); }
    }
    if constexpr (K == 11) { pg8::Gemm g{U, (const bf16*)(ws + WS_WO), MROWS, D, D, D}; pg8::StaticOrder S; S.init(MROWS, D, F.G, F.bid); EpiResid E{X, X + (size_t)NCTX * D, X, mod + 5 * D, 1.0f}; GEMM_PHASE(EpiResid, g, S, E); }
    if constexpr (K == 12) { norm_phase<false>(a, F, X, X + (size_t)NCTX * D, a.in[I_NF2], 6 * D, 7 * D); }
    if constexpr (K == 13) { pg8::Gemm g{U, (const bf16*)(ws + WS_W13B), MROWS, 2 * FF, D, D}; pg8::StaticOrder S; S.init(MROWS, 2 * FF, F.G, F.bid); EpiSwiGLU E{H}; GEMM_PHASE(EpiSwiGLU, g, S, E); }
    if constexpr (K == 14) { pg8::Gemm g{H, (const bf16*)(ws + WS_W2B), MROWS, D, FF, FF}; pg8::StaticOrder S; S.init(MROWS, D, F.G, F.bid); EpiResid E{X, X + (size_t)NCTX * D, X, mod + 8 * D, 0.5f}; GEMM_PHASE(EpiResid, g, S, E); }
    if constexpr (K == 15) { final_norm_phase(a, F); }
}
#ifndef PROGRAM
#define PROGRAM P(0) P(1) P(2) P(3) P(4) P(5) P(6) P(7) P(8) P(9) P(10) P(11) P(12) P(13) P(14) L(15)
#endif
__global__ void __launch_bounds__(512, 2) fwd_kernel(Args a) {
    extern __shared__ __attribute__((aligned(16))) unsigned char lds[];
    Frame F; F.lds = lds; F.tid = threadIdx.x; F.lane = F.tid & 63; F.wave = __builtin_amdgcn_readfirstlane(F.tid >> 6);
    F.G = gridDim.x; F.bid = blockIdx.x; F.gw = F.bid * 8 + F.wave; F.ngw = F.G * 8;
    volatile LAS unsigned* MISC = (volatile LAS unsigned*)((LAS unsigned char*)lds + MISC_OFF);
    if (F.tid < 64) MISC[F.tid] = 0u;
    __syncthreads();
    XcdBarrier bar = xcd_barrier_post((unsigned*)(a.ws + WS_CTL) + CW_BAR, MISC + 8);
#define P(k) run_phase<k>(a, F, (LAS unsigned char*)lds); xcd_barrier(bar);
#define L(k) run_phase<k>(a, F, (LAS unsigned char*)lds);
    PROGRAM
#undef P
#undef L
}

extern "C" void kernel_launch(void* const* d_in, const int* in_sizes, int n_in, void* d_out, int out_size, void* d_ws, size_t ws_size, hipStream_t stream) {
    static int grid = 0;
    if (grid == 0) {
        if (n_in != 31 || (size_t)out_size != OUT_END || ws_size < WS_END) { fprintf(stderr, "kernel_launch: unexpected shapes: n_in %d out %d ws %zu\n", n_in, out_size, ws_size); grid = -1; return; }
        int dev = 0, cus = 0, per_cu = 0;
        if (hipGetDevice(&dev) != hipSuccess || hipDeviceGetAttribute(&cus, hipDeviceAttributeMultiprocessorCount, dev) != hipSuccess) { grid = -1; return; }
        if (hipFuncSetAttribute((const void*)fwd_kernel, hipFuncAttributeMaxDynamicSharedMemorySize, LDS_BYTES) != hipSuccess) { fprintf(stderr, "kernel_launch: hipFuncSetAttribute failed\n"); grid = -1; return; }
        if (hipOccupancyMaxActiveBlocksPerMultiprocessor(&per_cu, (const void*)fwd_kernel, 512, LDS_BYTES) != hipSuccess || per_cu < 1) { fprintf(stderr, "kernel_launch: occupancy query says %d blocks per CU\n", per_cu); grid = -1; return; }
        (void)hipGetLastError();
        grid = cus * 1;
    }
    if (grid < 0) return;
    (void)hipMemsetAsync((char*)d_ws + WS_CTL, 0, CTL_ZERO_BYTES, stream);
    Args a{};
    for (int i = 0; i < 31; ++i) a.in[i] = (const float*)d_in[i];
    a.out = (float*)d_out; a.ws = (unsigned char*)d_ws;
    a.ph_lo = 0; a.ph_hi = NPHASE;
    void* args[] = {&a};
    hipError_t e = hipLaunchCooperativeKernel((const void*)fwd_kernel, dim3(grid), dim3(512), args, LDS_BYTES, stream);
    if (e != hipSuccess) fprintf(stderr, "kernel_launch: cooperative launch failed: %s (grid %d)\n", hipGetErrorString(e), grid);
}
```

```cpp
#include <hip/hip_runtime.h>
#include <cstdio>
#include <cstdint>
namespace pg8 {
#define PG8_LAS __attribute__((address_space(3)))
typedef unsigned short bf16_t;
typedef short bf16x8 __attribute__((ext_vector_type(8)));
typedef float f32x4 __attribute__((ext_vector_type(4)));
typedef unsigned u32x4 __attribute__((ext_vector_type(4)));
constexpr int BM = 256, BK = 64, HALF = 128, HTB = HALF * BK * 2  , STAGE_BYTES = 8 * HTB, NXCD = 8, WGM = 8;

__host__ __device__ __forceinline__ int lds_byte(int r, int c) { const int st = (r >> 4) * 2 + (c >> 5), rr = r & 15, cc = c & 31, ob = rr * 64 + cc * 2; return st * 1024 + (ob ^ (((ob >> 9) & 1) << 5)); }
__host__ __device__ __forceinline__ void stage_rc(int b, int& R, int& C) { const int st = b / 1024, sb = b % 1024, swz = sb ^ (((sb >> 9) & 1) << 5); R = (st >> 1) * 16 + swz / 64; C = (st & 1) * 32 + (swz % 64) / 2; }
__host__ __device__ __forceinline__ int perm32(int rho) { const int n = rho >> 4, i = rho & 15; return 8 * (i >> 2) + 4 * n + (i & 3); }

struct Unit { int pm, pn; };
struct Gemm { const bf16_t* A; const bf16_t* Bt; int M, N, K, lda; };

struct StaticOrder {
    int nM, nN, nwg, G, c;
    __host__ __device__ void init(int M, int N, int G_, int c_) { nM = M / BM; nN = N / BM; nwg = nM * nN; G = G_; c = c_; }
    __host__ __device__ bool next(int i, Unit& u) const {
        const long L = (long)i * G + c; if (L >= nwg) return false;
        int wgid = (int)L; { const int q = nwg / NXCD, r = nwg % NXCD, xcd = wgid % NXCD, off = wgid / NXCD; wgid = (xcd < r ? xcd * (q + 1) : r * (q + 1) + (xcd - r) * q) + off; }
        const int nig = WGM * nN, gid = wgid / nig, fm = gid * WGM, gsz = (nM - fm) < WGM ? (nM - fm) : WGM;
        u.pm = fm + ((wgid % nig) % gsz); u.pn = (wgid % nig) / gsz; return true;
    }
    __device__ __forceinline__ void a_ready(const Unit&) const {}
    __device__ __forceinline__ void done(const Unit&) const {}
};

__device__ __forceinline__ unsigned cvt_pk_bf16(float lo, float hi) { unsigned r; asm volatile("v_cvt_pk_bf16_f32 %0, %1, %2" : "=v"(r) : "v"(lo), "v"(hi)); return r; }
template <class Epi, class Sched, bool ALIGN_EPI = false, bool SP2 = false>
__device__ __forceinline__ void gemm_phase(PG8_LAS unsigned char* lds, const Gemm g, const Sched& S, const Epi& E) {
    int tid_l = threadIdx.x; asm volatile("" : "+v"(tid_l)); const int tid = tid_l, wid = __builtin_amdgcn_readfirstlane(tid >> 6), lane = tid & 63, wr = wid >> 2, wc = wid & 3, fr = lane & 15, fq = lane >> 4;
    const int K = g.K, nt = K / BK;
    unsigned voffA[2], voffB[2];
#pragma unroll
    for (int i = 0; i < 2; ++i) { int R, C; stage_rc(tid * 16 + i * 8192, R, C); const int Rb = Epi::PERM ? ((R & ~31) + perm32(R & 31)) : R;
        voffA[i] = (unsigned)(R * g.lda + C) * 2u; voffB[i] = (unsigned)(Rb * K + C) * 2u; }
    const size_t kstep = (size_t)(BK * 2);
    const size_t hstep = (size_t)HALF * K * 2;
    const size_t tstep = 2 * hstep; const size_t hstepA = (size_t)HALF * g.lda * 2, tstepA = 2 * hstepA;
    const unsigned ldsw = (unsigned)wid * 1024u;
    const int aoff = lds_byte(wr * 64 + fr, fq * 8), boff = lds_byte(wc * 32 + fr, fq * 8);
#define PG8_SA(b, h) (((b) * 2 + (h)) * HTB)
#define PG8_SB(b, h) ((4 + (b) * 2 + (h)) * HTB)
#define PG8_STAGE(bufoff, gbase, voff) do { _Pragma("unroll") for (int _i = 0; _i < 2; ++_i) \
        __builtin_amdgcn_global_load_lds((const unsigned*)((const char*)(gbase) + (voff)[_i]), (PG8_LAS unsigned*)(lds + (bufoff) + ldsw + _i * 8192), 16, 0, 0); } while (0)
#define PG8_LDA(dst, b, h) do { _Pragma("unroll") for (int m = 0; m < 4; ++m) _Pragma("unroll") for (int k = 0; k < 2; ++k) dst[m][k] = *(const PG8_LAS bf16x8*)(lds + PG8_SA(b, h) + aoff + m * 2048 + k * 1024); } while (0)
#define PG8_LDB(dst, b, h) do { _Pragma("unroll") for (int n = 0; n < 2; ++n) _Pragma("unroll") for (int k = 0; k < 2; ++k) dst[n][k] = *(const PG8_LAS bf16x8*)(lds + PG8_SB(b, h) + boff + n * 2048 + k * 1024); } while (0)
#define PG8_MMA(ai, bj, At, Bt) do { __builtin_amdgcn_s_setprio(1); _Pragma("unroll") for (int m = 0; m < 4; ++m) _Pragma("unroll") for (int n = 0; n < 2; ++n) _Pragma("unroll") for (int k = 0; k < 2; ++k) \
        acc[ai][bj][m][n] = __builtin_amdgcn_mfma_f32_16x16x32_bf16(Bt[n][k], At[m][k], acc[ai][bj][m][n], 0, 0, 0); __builtin_amdgcn_s_setprio(0); } while (0)
#define PG8_WAIT_V(n) asm volatile("s_waitcnt vmcnt(" #n ")" ::: "memory")
#define PG8_WAIT_L(n) asm volatile("s_waitcnt lgkmcnt(" #n ")" ::: "memory")
#define PG8_BAR __builtin_amdgcn_s_barrier()
#define PG8_SCHED __builtin_amdgcn_sched_barrier(0)
    Unit cur, nxt; int ui = 0;
    if (!S.next(0, cur)) return;
    f32x4 acc[2][2][4][2];
#pragma unroll
    for (int a = 0; a < 2; ++a)
#pragma unroll
        for (int b = 0; b < 2; ++b)
#pragma unroll
            for (int m = 0; m < 4; ++m)
#pragma unroll
                for (int n = 0; n < 2; ++n) acc[a][b][m][n] = (f32x4){0.f, 0.f, 0.f, 0.f};
    bf16x8 At[4][2], B0[2][2], B1[2][2];
    const char* cA = (const char*)g.A + (size_t)cur.pm * tstepA; const char* cB = (const char*)g.Bt + (size_t)cur.pn * tstep;
    S.a_ready(cur);
    if constexpr (SP2) {
        PG8_STAGE(PG8_SB(0, 0), cB, voffB); PG8_STAGE(PG8_SB(0, 1), cB + hstep, voffB); PG8_STAGE(PG8_SA(0, 0), cA, voffA); PG8_STAGE(PG8_SA(0, 1), cA + hstepA, voffA);
        if (wr == 1) PG8_BAR;
        PG8_WAIT_V(2); PG8_BAR;
        PG8_STAGE(PG8_SB(1, 0), cB + kstep, voffB); PG8_STAGE(PG8_SA(1, 0), cA + kstep, voffA); PG8_STAGE(PG8_SB(1, 1), cB + hstep + kstep, voffB);
        PG8_WAIT_V(6); PG8_BAR;
    } else {
        PG8_STAGE(PG8_SB(0, 0), cB, voffB); PG8_STAGE(PG8_SA(0, 0), cA, voffA); PG8_STAGE(PG8_SB(0, 1), cB + hstep, voffB); PG8_STAGE(PG8_SA(0, 1), cA + hstepA, voffA);
        if (wr == 1) PG8_BAR;
        PG8_WAIT_V(4); PG8_BAR;
        PG8_STAGE(PG8_SB(1, 0), cB + kstep, voffB); PG8_STAGE(PG8_SA(1, 0), cA + kstep, voffA); PG8_STAGE(PG8_SB(1, 1), cB + hstep + kstep, voffB);
        PG8_WAIT_V(6); PG8_BAR;
    }
    for (;;) {
        const bool has_next = S.next(ui + 1, nxt);
        const char* nA = has_next ? (const char*)g.A + (size_t)nxt.pm * tstepA : cA; const char* nB = has_next ? (const char*)g.Bt + (size_t)nxt.pn * tstep : cB;
        for (int t = 0; t < nt; t += 2) {
            const bool last = (t == nt - 2);
            const char* a1 = cA + (size_t)(t + 1) * kstep;
            const char* a2 = last ? nA : cA + (size_t)(t + 2) * kstep; const char* b2 = last ? nB : cB + (size_t)(t + 2) * kstep;
            const char* a3 = a2 + kstep; const char* b3 = b2 + kstep;
            if (last && has_next) S.a_ready(nxt);
            if constexpr (SP2) {
            PG8_LDB(B0, 0, 0); PG8_LDB(B1, 0, 1); PG8_SCHED; PG8_LDA(At, 0, 0); PG8_STAGE(PG8_SA(1, 1), a1 + hstepA, voffA);
            PG8_WAIT_V(8); PG8_WAIT_L(0); PG8_BAR; PG8_MMA(0, 0, At, B0); PG8_MMA(0, 1, At, B1); PG8_BAR; PG8_SCHED;
            PG8_LDA(At, 0, 1); PG8_STAGE(PG8_SB(0, 0), b2, voffB); PG8_STAGE(PG8_SB(0, 1), b2 + hstep, voffB); PG8_STAGE(PG8_SA(0, 0), a2, voffA);
            PG8_WAIT_V(8); PG8_WAIT_L(0); PG8_BAR; PG8_MMA(1, 0, At, B0); PG8_MMA(1, 1, At, B1); PG8_BAR; PG8_SCHED;
            PG8_LDB(B0, 1, 0); PG8_LDB(B1, 1, 1); PG8_SCHED; PG8_LDA(At, 1, 0); PG8_STAGE(PG8_SA(0, 1), a2 + hstepA, voffA);
            PG8_WAIT_V(8); PG8_WAIT_L(0); PG8_BAR; PG8_MMA(0, 0, At, B0); PG8_MMA(0, 1, At, B1); PG8_BAR; PG8_SCHED;
            PG8_LDA(At, 1, 1); PG8_STAGE(PG8_SB(1, 0), b3, voffB); PG8_STAGE(PG8_SB(1, 1), b3 + hstep, voffB); PG8_STAGE(PG8_SA(1, 0), a3, voffA);
            PG8_WAIT_V(8); PG8_WAIT_L(0); PG8_BAR; PG8_MMA(1, 0, At, B0); PG8_MMA(1, 1, At, B1); PG8_BAR; PG8_SCHED;
            } else {
            PG8_LDB(B0, 0, 0); PG8_SCHED; PG8_LDA(At, 0, 0); PG8_STAGE(PG8_SA(1, 1), a1 + hstepA, voffA);
            PG8_WAIT_L(8); PG8_BAR; PG8_WAIT_L(0); PG8_MMA(0, 0, At, B0); PG8_BAR; PG8_SCHED;
            PG8_LDB(B1, 0, 1); PG8_STAGE(PG8_SB(0, 0), b2, voffB);
            PG8_BAR; PG8_WAIT_L(0); PG8_MMA(0, 1, At, B1); PG8_BAR;
            PG8_LDA(At, 0, 1); PG8_STAGE(PG8_SA(0, 0), a2, voffA);
            PG8_BAR; PG8_WAIT_L(0); PG8_MMA(1, 0, At, B0); PG8_BAR; PG8_SCHED;
            PG8_STAGE(PG8_SB(0, 1), b2 + hstep, voffB);
            PG8_WAIT_V(6); PG8_BAR; PG8_MMA(1, 1, At, B1); PG8_BAR;
            PG8_LDB(B0, 1, 0); PG8_SCHED; PG8_LDA(At, 1, 0); PG8_STAGE(PG8_SA(0, 1), a2 + hstepA, voffA);
            PG8_WAIT_L(8); PG8_BAR; PG8_WAIT_L(0); PG8_MMA(0, 0, At, B0); PG8_BAR; PG8_SCHED;
            PG8_LDB(B1, 1, 1); PG8_STAGE(PG8_SB(1, 0), b3, voffB);
            PG8_BAR; PG8_WAIT_L(0); PG8_MMA(0, 1, At, B1); PG8_BAR;
            PG8_LDA(At, 1, 1); PG8_STAGE(PG8_SA(1, 0), a3, voffA);
            PG8_BAR; PG8_WAIT_L(0); PG8_MMA(1, 0, At, B0); PG8_BAR; PG8_SCHED;
            PG8_STAGE(PG8_SB(1, 1), b3 + hstep, voffB);
            PG8_WAIT_V(6); PG8_BAR; PG8_MMA(1, 1, At, B1); PG8_BAR;
            }
        }
        if constexpr (ALIGN_EPI) { if (wr == 0) PG8_BAR; }
        if constexpr (!Epi::AFTER_DRAIN) { E(acc, cur, wr, wc, fr, fq); S.done(cur); }
        if (!has_next) break;
#pragma unroll
        for (int a = 0; a < 2; ++a)
#pragma unroll
            for (int b = 0; b < 2; ++b)
#pragma unroll
                for (int m = 0; m < 4; ++m)
#pragma unroll
                    for (int n = 0; n < 2; ++n) acc[a][b][m][n] = (f32x4){0.f, 0.f, 0.f, 0.f};
        cur = nxt; cA = nA; cB = nB; ++ui;
        if constexpr (ALIGN_EPI) { if (wr == 1) PG8_BAR; }
    }
    PG8_WAIT_V(0);
    if constexpr (!ALIGN_EPI) { if (wr == 0) PG8_BAR; }
    PG8_BAR;
    if constexpr (Epi::AFTER_DRAIN) { E.fused(acc, cur, wr, wc, fr, fq, lds, wid, lane); S.done(cur); }
#undef PG8_SA
#undef PG8_SB
#undef PG8_STAGE
#undef PG8_LDA
#undef PG8_LDB
#undef PG8_MMA
#undef PG8_WAIT_V
#undef PG8_WAIT_L
#undef PG8_BAR
#undef PG8_SCHED
}
}

constexpr int D = 1024, NCTX = 4096, MROWS = 12288, FF = 2816;
constexpr int CH = 128, NCHUNK = 96, NHEAD = 4;
constexpr int PA_LD = 4096;
constexpr int C_RQ = 0, C_RK = 512, C_RV = 1024, C_MQ = 2048, C_MK = 2560, C_MV = 3072, C_MO = 3584;
constexpr int MODW = 9216;
constexpr float EPS_RMS = 1e-6f, EPS_GN = 1e-5f;
constexpr size_t OUT_Y = 0, OUT_SRET = (size_t)MROWS * D, OUT_SC = OUT_SRET + 16ull * 2 * 4 * 128 * 256, OUT_SN = OUT_SC + 16ull * 2 * 4 * 128 * 128, OUT_SM = OUT_SN + 16ull * 2 * 4 * 128, OUT_END = OUT_SM + 128;
constexpr size_t MiB = 1u << 20, KiB = 1024;
constexpr size_t WS_CTL = 0, CTL_ZERO_BYTES = 64 * KiB;
constexpr size_t WS_MOD = 1 * MiB;
constexpr size_t WS_WG = 1 * MiB + 384 * KiB;
constexpr size_t WS_ROPE = 2 * MiB;
constexpr size_t WS_IG = 2 * MiB + 512 * KiB;
constexpr size_t WS_LF = WS_IG + 384 * KiB;
constexpr size_t WS_MN = WS_LF + 384 * KiB;
constexpr size_t WS_MS = WS_MN + 384 * KiB;
constexpr size_t WS_W13A = 4 * MiB, WS_W2A = 15 * MiB, WS_W13B = 20 * MiB + 512 * KiB, WS_W2B = 31 * MiB + 512 * KiB;
constexpr size_t WS_WIN = 37 * MiB, WS_WR = 51 * MiB, WS_WM = 53 * MiB, WS_WO = 54 * MiB;
constexpr size_t WS_U = 56 * MiB;
constexpr size_t WS_BIG = 80 * MiB;
constexpr size_t WS_H = WS_BIG;
constexpr size_t WS_PA = WS_BIG;
constexpr size_t WS_RS = 176 * MiB;
constexpr size_t WS_MC = 224 * MiB;
constexpr size_t WS_BG = WS_RS;
constexpr size_t WS_T1 = WS_MC;
constexpr size_t WS_END = 248 * MiB;
static_assert(WS_MS + 16 * KiB <= WS_W13A, "ws map");
constexpr int CW_BAR = 1024;

constexpr int LDS_BYTES = 147456;
constexpr int RING_BYTES = 131072;
constexpr int MISC_OFF = LDS_BYTES - 256;

#define GAS __attribute__((address_space(1)))
#define LAS __attribute__((address_space(3)))
typedef unsigned short bf16;
typedef unsigned v4u __attribute__((ext_vector_type(4)));
typedef unsigned v2u __attribute__((ext_vector_type(2)));
typedef float f32x4 __attribute__((ext_vector_type(4)));
typedef GAS unsigned gu32;
#define RLX_AGENT __ATOMIC_RELAXED, __HIP_MEMORY_SCOPE_AGENT
#define LDS_WAIT() asm volatile("s_waitcnt lgkmcnt(0)" ::: "memory")
#define VM_WAIT() asm volatile("s_waitcnt vmcnt(0)" ::: "memory")
__device__ __forceinline__ unsigned f2bf(float f) { unsigned u = __builtin_bit_cast(unsigned, f); return (u + 0x7fffu + ((u >> 16) & 1u)) >> 16; }
__device__ __forceinline__ unsigned pk2(float lo, float hi) { return f2bf(lo) | (f2bf(hi) << 16); }
__device__ __forceinline__ float bf2f(unsigned short b) { return __builtin_bit_cast(float, (unsigned)b << 16); }
__device__ __forceinline__ float bflo(unsigned w) { return __builtin_bit_cast(float, w << 16); }
__device__ __forceinline__ float bfhi(unsigned w) { return __builtin_bit_cast(float, w & 0xffff0000u); }
__device__ __forceinline__ float silu_f(float x) { return x / (1.f + __expf(-x)); }
__device__ __forceinline__ float sigmoid_f(float x) { return 1.f / (1.f + __expf(-x)); }
__device__ __forceinline__ float logsigmoid_f(float x) { return fminf(x, 0.f) - log1pf(expf(-fabsf(x))); }
__device__ __forceinline__ float wave_sum(float v) {
#pragma unroll
    for (int o = 1; o < 64; o <<= 1) v += __shfl_xor(v, o);
    return v;
}
#define XB_TMO      128
#define XB_XCNT(j)  (256  + 64 * (j))
#define XB_XSUB(j)  (1280 + 64 * (j))
#define XB_XGEN(j)  (2304 + 64 * (j))
#define XB_TOP      3328
#define XB_TOPGEN   3392
#define XCD_BAR_WORDS 3456
#define XB_SPIN_CAP (1u << 18)

__device__ __forceinline__ unsigned xb_ld(unsigned* p)              { return __hip_atomic_load(p, __ATOMIC_RELAXED, __HIP_MEMORY_SCOPE_AGENT); }
__device__ __forceinline__ unsigned xb_add(unsigned* p, unsigned v) { return __hip_atomic_fetch_add(p, v, __ATOMIC_RELAXED, __HIP_MEMORY_SCOPE_AGENT); }
__device__ __forceinline__ unsigned xb_xcc_id() { return (unsigned)__builtin_amdgcn_s_getreg((3 << 11) | 20) & 0xFu; }
#define XB_SPIN(cond, bar) do { unsigned _sp = 0; while (cond) { __builtin_amdgcn_s_sleep(1); \
    if ((++_sp & 255u) == 0u) { if (xb_ld(&(bar)[XB_TMO])) break; if (_sp > XB_SPIN_CAP) { atomicAdd(&(bar)[XB_TMO], 1u); break; } } } } while (0)

struct XcdBarrier {
    unsigned* bar; unsigned x;
    volatile LAS unsigned* st;
};

__device__ __forceinline__ XcdBarrier xcd_barrier_post(unsigned* bar, volatile LAS unsigned* st) {
    XcdBarrier b; b.bar = bar; b.x = xb_xcc_id(); b.st = st;
    if (threadIdx.x == 0) (void)xb_add(&bar[XB_XCNT(b.x)], 1u);
    return b;
}
__device__ __forceinline__ void xcd_barrier_complete(unsigned* bar, unsigned x, unsigned& nloc, unsigned& nx) {
    const unsigned G = gridDim.x * gridDim.y * gridDim.z;
    unsigned sum, cnt, mine, sp = 0u;
    for (;;) {
        sum = 0u; cnt = 0u; mine = 0u;
#pragma unroll
        for (unsigned j = 0; j < 16; ++j) { const unsigned c = xb_ld(&bar[XB_XCNT(j)]); sum += c; cnt += (c > 0u) ? 1u : 0u; mine = (j == x) ? c : mine; }
        if (sum == G) break;
        __builtin_amdgcn_s_sleep(1);
        if ((++sp & 255u) == 0u) { if (xb_ld(&bar[XB_TMO])) break; if (sp > XB_SPIN_CAP) { atomicAdd(&bar[XB_TMO], 1u); break; } }
    }
    nloc = mine > 0u ? mine : 1u; nx = cnt > 0u ? cnt : 1u;
}

__device__ __forceinline__ void xcd_barrier(const XcdBarrier& b) {
    asm volatile("s_waitcnt vmcnt(0)" ::: "memory");
    __syncthreads();
    if (threadIdx.x == 0) {
        unsigned* bar = b.bar;
        __builtin_amdgcn_s_waitcnt(0);
        unsigned nloc = b.st[0], nx = b.st[1];
        if (nloc == 0u) { xcd_barrier_complete(bar, b.x, nloc, nx); b.st[0] = nloc; b.st[1] = nx; }
        const unsigned old = xb_add(&bar[XB_XSUB(b.x)], 1u);
        const unsigned gen = old / nloc;
        if (old + 1u == (gen + 1u) * nloc) {
            __builtin_amdgcn_fence(__ATOMIC_RELEASE, "agent");
            asm volatile("s_waitcnt vmcnt(0)" ::: "memory");
            const unsigned og = xb_add(&bar[XB_TOP], 1u);
            const unsigned tg = og / nx;
            if (og + 1u == (tg + 1u) * nx) xb_add(&bar[XB_TOPGEN], 1u);
            else XB_SPIN(xb_ld(&bar[XB_TOPGEN]) == tg, bar);
            __builtin_amdgcn_fence(__ATOMIC_ACQUIRE, "agent");
            xb_add(&bar[XB_XGEN(b.x)], 1u);
            asm volatile("s_waitcnt vmcnt(0)" ::: "memory");
        } else {
            XB_SPIN(xb_ld(&bar[XB_XGEN(b.x)]) == gen, bar);
            __builtin_amdgcn_fence(__ATOMIC_ACQUIRE, "agent");
            asm volatile("s_waitcnt vmcnt(0)" ::: "memory");
        }
    }
    __syncthreads();
}

struct Args { const float* in[31]; float* out; unsigned char* ws; int ph_lo, ph_hi; };
enum { I_XP = 0, I_XS, I_C, I_SRET, I_SC, I_SN, I_SM, I_CCTX, I_WADA, I_BADA, I_NF1, I_W1A, I_W3A, I_W2A, I_NMIX, I_WIN, I_CONVW, I_CONVB,
       I_DECAY, I_BIG, I_BFG, I_RETGN, I_MGN, I_WRUP, I_WMUP, I_WOUT, I_NF2, I_W1B, I_W3B, I_W2B, I_NFIN };

struct Frame {
    unsigned char* lds;
    int tid, lane, wave, G, bid, gw, ngw;
};

__device__ __forceinline__ int mod_row(int row) { return row < NCTX ? 0 : 1 + ((row - NCTX) >> 10); }

__device__ __forceinline__ int rope_perm(int p) { const int s = p >> 6, i = p & 63; return 8 * (i >> 2) + 4 * s + (i & 3); }
template <int MODE>
__device__ __forceinline__ void p0_tr_item(const float* W, int ldw, int col0, int K, int ncols, bf16* WT, int row_off, float* scr, int item, int lane) {
    const int nblk = ncols / 32, kb = item / nblk, nb = item % nblk, k0 = 64 * kb, n0 = 32 * nb;
    float tv[32];
#pragma unroll
    for (int i = 0; i < 32; ++i) tv[i] = W[(size_t)(k0 + 2 * i + (lane >> 5)) * ldw + col0 + n0 + (lane & 31)];
#pragma unroll
    for (int i = 0; i < 32; ++i) scr[(2 * i + (lane >> 5)) * 33 + (lane & 31)] = tv[i];
    LDS_WAIT(); asm volatile("" ::: "memory");
    const int c = lane & 7;
#pragma unroll
    for (int j = 0; j < 4; ++j) { const int n = (lane >> 3) + 8 * j, nn = n0 + n; const float* s = scr + (8 * c) * 33 + n;
        int drow;
        if (MODE == 0) drow = row_off + nn; else if (MODE == 1) drow = row_off + (nn & ~127) + rope_perm(nn & 127); else drow = row_off + 256 * (nn >> 7) + (nn & 127);
        v4u o; o.x = pk2(s[0 * 33], s[1 * 33]); o.y = pk2(s[2 * 33], s[3 * 33]); o.z = pk2(s[4 * 33], s[5 * 33]); o.w = pk2(s[6 * 33], s[7 * 33]);
        *(v4u*)(WT + (size_t)drow * K + k0 + 8 * c) = o; }
    LDS_WAIT(); asm volatile("" ::: "memory");
}

__device__ __forceinline__ void p0_prologue(const Args& a, const Frame& F) {
    unsigned char* ws = a.ws;
    float* mod = (float*)(ws + WS_MOD);
    if (F.bid < MODW / 64) {
        float* sc = (float*)F.lds;
        float* part = (float*)(F.lds + 40960);
        for (int idx = F.tid; idx < 9 * 1024; idx += 512) { const int r = idx >> 10, k = idx & 1023; const float v = r == 0 ? a.in[I_CCTX][k] : a.in[I_C][(r - 1) * 1024 + k]; sc[idx] = v / (1.f + expf(-v)); }
        __syncthreads();
        const int c0 = 64 * F.bid, k0 = 128 * F.wave; const float* wp = a.in[I_WADA] + (size_t)k0 * MODW + c0 + F.lane;
        float acc[9];
#pragma unroll
        for (int r = 0; r < 9; ++r) acc[r] = 0.f;
#pragma unroll 32
        for (int kk = 0; kk < 128; ++kk) { const float wv = wp[(size_t)kk * MODW];
#pragma unroll
            for (int r = 0; r < 9; ++r) acc[r] += sc[r * 1024 + k0 + kk] * wv; }
#pragma unroll
        for (int r = 0; r < 9; ++r) part[(F.wave * 9 + r) * 64 + F.lane] = acc[r];
        __syncthreads();
        for (int idx = F.tid; idx < 9 * 64; idx += 512) { const int r = idx >> 6, l = idx & 63; float s = 0.f;
#pragma unroll
            for (int w = 0; w < 8; ++w) s += part[(w * 9 + r) * 64 + l];
            mod[r * MODW + c0 + l] = s + a.in[I_BADA][c0 + l]; }
        __syncthreads();
    }
    { float* wg = (float*)(ws + WS_WG); const int gt = F.bid * 512 + F.tid, ngt = F.G * 512;
      for (int idx = gt; idx < 16 * 1024; idx += ngt) { const int c = idx >> 10, k = idx & 1023; wg[idx] = a.in[I_WIN][(size_t)k * 7184 + 5120 + c]; }
      float2* rope = (float2*)(ws + WS_ROPE);
      for (int idx = gt; idx < 1024 * 64; idx += ngt) { const int t = idx >> 6, i = idx & 63, f = i & 31; const float freq = exp2f(-(float)f * (13.287712379549449f / 32.f));
          const float pos = (float)(i < 32 ? (t >> 6) : (t & 63)); const float ang = pos * freq; rope[idx] = make_float2(cosf(ang), sinf(ang)); } }
    float* scr = (float*)(F.lds + F.wave * 16384);
    bf16* W13A = (bf16*)(ws + WS_W13A); bf16* W2A = (bf16*)(ws + WS_W2A); bf16* W13B = (bf16*)(ws + WS_W13B); bf16* W2B = (bf16*)(ws + WS_W2B);
    bf16* WIN = (bf16*)(ws + WS_WIN); bf16* WR = (bf16*)(ws + WS_WR); bf16* WM = (bf16*)(ws + WS_WM); bf16* WO = (bf16*)(ws + WS_WO);
    constexpr int I_UP = 16 * 88, I_DN = 44 * 32, I_512 = 16 * 32, I_1024 = 16 * 64, I_MUP = 8 * 32;
    constexpr int NITEMS = 4 * I_UP + 2 * I_DN + (I_512 + I_512 + I_1024 + I_512 + I_1024) + I_512 + I_MUP + I_512;
    for (int it = F.gw; it < NITEMS; it += F.ngw) {
        int r = it;
        if (r < I_UP) { p0_tr_item<2>(a.in[I_W1A], FF, 0, D, FF, W13A, 0, scr, r, F.lane); continue; } r -= I_UP;
        if (r < I_UP) { p0_tr_item<2>(a.in[I_W3A], FF, 0, D, FF, W13A, 128, scr, r, F.lane); continue; } r -= I_UP;
        if (r < I_DN) { p0_tr_item<0>(a.in[I_W2A], D, 0, FF, D, W2A, 0, scr, r, F.lane); continue; } r -= I_DN;
        if (r < I_UP) { p0_tr_item<2>(a.in[I_W1B], FF, 0, D, FF, W13B, 0, scr, r, F.lane); continue; } r -= I_UP;
        if (r < I_UP) { p0_tr_item<2>(a.in[I_W3B], FF, 0, D, FF, W13B, 128, scr, r, F.lane); continue; } r -= I_UP;
        if (r < I_DN) { p0_tr_item<0>(a.in[I_W2B], D, 0, FF, D, W2B, 0, scr, r, F.lane); continue; } r -= I_DN;
        if (r < I_512) { p0_tr_item<1>(a.in[I_WIN], 7184, 0, D, 1024, WIN, 0, scr, r, F.lane); continue; } r -= I_512;
        if (r < I_512) { p0_tr_item<0>(a.in[I_WIN], 7184, 1024, D, 1024, WIN, 1024, scr, r, F.lane); continue; } r -= I_512;
        if (r < I_1024) { p0_tr_item<0>(a.in[I_WIN], 7184, 3072, D, 2048, WIN, 2048, scr, r, F.lane); continue; } r -= I_1024;
        if (r < I_512) { p0_tr_item<0>(a.in[I_WIN], 7184, 2048, D, 1024, WIN, 4096, scr, r, F.lane); continue; } r -= I_512;
        if (r < I_1024) { p0_tr_item<0>(a.in[I_WIN], 7184, 5136, D, 2048, WIN, 5120, scr, r, F.lane); continue; } r -= I_1024;
        if (r < I_512) { p0_tr_item<0>(a.in[I_WRUP], D, 0, D, D, WR, 0, scr, r, F.lane); continue; } r -= I_512;
        if (r < I_MUP) { p0_tr_item<0>(a.in[I_WMUP], D, 0, 512, D, WM, 0, scr, r, F.lane); continue; } r -= I_MUP;
        p0_tr_item<0>(a.in[I_WOUT], D, 0, D, D, WO, 0, scr, r, F.lane);
    }
}

template <bool GATES>
__device__ __forceinline__ void norm_phase(const Args& a, const Frame& F, const float* x0, const float* x1, const float* nw, int sh_off, int sc_off) {
    const float* mod = (const float*)(a.ws + WS_MOD); bf16* U = (bf16*)(a.ws + WS_U);
    float* wgs = (float*)F.lds;
    if (GATES) { const float* wg = (const float*)(a.ws + WS_WG); for (int i = F.tid; i < 16 * 1024 / 4; i += 512) ((f32x4*)wgs)[i] = ((const f32x4*)wg)[i]; __syncthreads(); }
    f32x4 nwv[4];
#pragma unroll
    for (int j = 0; j < 4; ++j) nwv[j] = ((const f32x4*)nw)[F.lane + 64 * j];
    for (int row = F.gw; row < MROWS; row += F.ngw) {
        const float* xr = row < NCTX ? x0 + (size_t)row * D : x1 + (size_t)(row - NCTX) * D;
        const int mr = mod_row(row); const float* shp = mod + mr * MODW + sh_off; const float* scp = mod + mr * MODW + sc_off;
        f32x4 v[4]; float ss = 0.f;
#pragma unroll
        for (int j = 0; j < 4; ++j) { v[j] = ((const f32x4*)xr)[F.lane + 64 * j]; ss += (v[j].x * v[j].x + v[j].y * v[j].y) + (v[j].z * v[j].z + v[j].w * v[j].w); }
        const float rstd = 1.f / sqrtf(wave_sum(ss) * (1.f / D) + EPS_RMS);
        unsigned long long* o8 = (unsigned long long*)(U + (size_t)row * D) + F.lane;
#pragma unroll
        for (int j = 0; j < 4; ++j) { const f32x4 sh = ((const f32x4*)shp)[F.lane + 64 * j], sc = ((const f32x4*)scp)[F.lane + 64 * j];
            v[j] = v[j] * rstd * nwv[j] * (sc + 1.f) + sh;
            o8[64 * j] = (unsigned long long)pk2(v[j].x, v[j].y) | ((unsigned long long)pk2(v[j].z, v[j].w) << 32); }
        if (GATES) {
            float* IG = (float*)(a.ws + WS_IG); float* LF = (float*)(a.ws + WS_LF);
            float p[16];
#pragma unroll
            for (int c = 0; c < 16; ++c) { float acc = 0.f;
#pragma unroll
                for (int j = 0; j < 4; ++j) { const f32x4 w = ((const f32x4*)(wgs + c * 1024))[F.lane + 64 * j]; acc += (v[j].x * w.x + v[j].y * w.y) + (v[j].z * w.z + v[j].w * w.w); }
                p[c] = acc; if ((c & 1) == 1) __builtin_amdgcn_sched_barrier(0); }
            const bool b5 = F.lane & 32, b4 = F.lane & 16, b3 = F.lane & 8, b2 = F.lane & 4;
            float q[8], r4[4], s2[2];
#pragma unroll
            for (int c = 0; c < 8; ++c) { const float snd = b5 ? p[c] : p[c + 8], kp = b5 ? p[c + 8] : p[c]; q[c] = kp + __shfl_xor(snd, 32); }
#pragma unroll
            for (int c = 0; c < 4; ++c) { const float snd = b4 ? q[c] : q[c + 4], kp = b4 ? q[c + 4] : q[c]; r4[c] = kp + __shfl_xor(snd, 16); }
#pragma unroll
            for (int c = 0; c < 2; ++c) { const float snd = b3 ? r4[c] : r4[c + 2], kp = b3 ? r4[c + 2] : r4[c]; s2[c] = kp + __shfl_xor(snd, 8); }
            float t = (b2 ? s2[1] : s2[0]) + __shfl_xor(b2 ? s2[0] : s2[1], 4);
            t += __shfl_xor(t, 1); t += __shfl_xor(t, 2);
            const int col = ((F.lane >> 5) & 1) * 8 + ((F.lane >> 4) & 1) * 4 + ((F.lane >> 3) & 1) * 2 + ((F.lane >> 2) & 1);
            if ((F.lane & 3) == 0) { if (col < 8) IG[(size_t)row * 8 + col] = t + a.in[I_BIG][col]; else LF[(size_t)row * 8 + col - 8] = logsigmoid_f(t + a.in[I_BFG][col - 8]); }
        }
    }
    if (GATES) __syncthreads();
}
__device__ __forceinline__ void final_norm_phase(const Args& a, const Frame& F) {
    f32x4 nwv[4];
#pragma unroll
    for (int j = 0; j < 4; ++j) nwv[j] = ((const f32x4*)a.in[I_NFIN])[F.lane + 64 * j];
    for (int row = F.gw; row < MROWS; row += F.ngw) {
        f32x4* xr = (f32x4*)(a.out + (size_t)row * D); f32x4 v[4]; float ss = 0.f;
#pragma unroll
        for (int j = 0; j < 4; ++j) { v[j] = xr[F.lane + 64 * j]; ss += (v[j].x * v[j].x + v[j].y * v[j].y) + (v[j].z * v[j].z + v[j].w * v[j].w); }
        const float rstd = 1.f / sqrtf(wave_sum(ss) * (1.f / D) + EPS_RMS);
#pragma unroll
        for (int j = 0; j < 4; ++j) xr[F.lane + 64 * j] = v[j] * rstd * nwv[j];
    }
}

using pg8::f32x4; using pg8::Unit; using pg8::cvt_pk_bf16;
struct EpiSwiGLU {
    static constexpr bool PERM = true, AFTER_DRAIN = false; bf16* H;
    __device__ __forceinline__ void operator()(const pg8::f32x4 (&acc)[2][2][4][2], const Unit& u, int wr, int wc, int fr, int fq) const {
        const int row0 = u.pm * 256 + wr * 64 + fr, col0 = u.pn * 128 + wc * 32 + 8 * fq;
#pragma unroll
        for (int ai = 0; ai < 2; ++ai)
#pragma unroll
            for (int m = 0; m < 4; ++m) { bf16* rowp = H + (size_t)(row0 + ai * 128 + m * 16) * FF + col0;
                const pg8::f32x4 g0 = acc[ai][0][m][0], g1 = acc[ai][0][m][1], u0 = acc[ai][1][m][0], u1 = acc[ai][1][m][1];
                v4u w; w.x = cvt_pk_bf16(silu_f(g0[0]) * u0[0], silu_f(g0[1]) * u0[1]); w.y = cvt_pk_bf16(silu_f(g0[2]) * u0[2], silu_f(g0[3]) * u0[3]);
                w.z = cvt_pk_bf16(silu_f(g1[0]) * u1[0], silu_f(g1[1]) * u1[1]); w.w = cvt_pk_bf16(silu_f(g1[2]) * u1[2], silu_f(g1[3]) * u1[3]);
                *(v4u*)rowp = w; }
    }
};
struct EpiResid {
    static constexpr bool PERM = false, AFTER_DRAIN = false; const float* base0; const float* base1; float* X; const float* gate; float scale;
    __device__ __forceinline__ void operator()(const pg8::f32x4 (&acc)[2][2][4][2], const Unit& u, int wr, int wc, int fr, int fq) const {
        const int row0 = u.pm * 256 + wr * 64 + fr, col0 = u.pn * 256 + wc * 32 + 4 * fq; const int mr = mod_row(u.pm * 256);
        pg8::f32x4 gv[2][2];
#pragma unroll
        for (int bj = 0; bj < 2; ++bj)
#pragma unroll
            for (int n = 0; n < 2; ++n) gv[bj][n] = *(const pg8::f32x4*)(gate + mr * MODW + col0 + bj * 128 + n * 16) * scale;
#pragma unroll
        for (int ai = 0; ai < 2; ++ai)
#pragma unroll
            for (int m = 0; m < 4; ++m) { const int row = row0 + ai * 128 + m * 16;
                const float* bp = (row < NCTX ? base0 + (size_t)row * D : base1 + (size_t)(row - NCTX) * D) + col0; float* xp = X + (size_t)row * D + col0;
#pragma unroll
                for (int bj = 0; bj < 2; ++bj)
#pragma unroll
                    for (int n = 0; n < 2; ++n) { const pg8::f32x4 b = *(const pg8::f32x4*)(bp + bj * 128 + n * 16); *(pg8::f32x4*)(xp + bj * 128 + n * 16) = b + gv[bj][n] * acc[ai][bj][m][n]; } }
    }
};
struct EpiProjA {
    static constexpr bool PERM = true, AFTER_DRAIN = false; bf16* P; const float2* rope;
    __device__ __forceinline__ void operator()(const pg8::f32x4 (&acc)[2][2][4][2], const Unit& u, int wr, int wc, int fr, int fq) const {
        const int row0 = u.pm * 256 + wr * 64 + fr;
        if (u.pn < 4) {
            const bool isk = u.pn >= 2, lat = u.pm >= 16; const float scl = isk ? 0.08838834764831845f : 1.f; const int q4 = 4 * wc + fq;
#pragma unroll
            for (int ai = 0; ai < 2; ++ai)
#pragma unroll
                for (int m = 0; m < 4; ++m) { const int row = row0 + ai * 128 + m * 16; const int t = (row - NCTX) & 1023;
#pragma unroll
                    for (int bj = 0; bj < 2; ++bj) { const int hh = 2 * (u.pn & 1) + bj; bf16* op = P + (size_t)row * PA_LD + (isk ? C_RK : C_RQ) + 128 * hh + 4 * q4;
                        pg8::f32x4 x1 = acc[ai][bj][m][0] * scl, x2 = acc[ai][bj][m][1] * scl;
                        if (lat) { const float2* cs = rope + t * 64 + 4 * q4;
#pragma unroll
                            for (int j = 0; j < 4; ++j) { const float2 c = cs[j]; const float a1 = x1[j], a2 = x2[j]; x1[j] = a1 * c.x - a2 * c.y; x2[j] = a2 * c.x + a1 * c.y; } }
                        v2u w1, w2; w1.x = cvt_pk_bf16(x1[0], x1[1]); w1.y = cvt_pk_bf16(x1[2], x1[3]); w2.x = cvt_pk_bf16(x2[0], x2[1]); w2.y = cvt_pk_bf16(x2[2], x2[3]);
                        *(v2u*)op = w1; *(v2u*)(op + 64) = w2; } }
        } else {
            const bool sg = u.pn >= 14; const int col0 = u.pn * 256 + wc * 32 + 8 * fq;
#pragma unroll
            for (int ai = 0; ai < 2; ++ai)
#pragma unroll
                for (int m = 0; m < 4; ++m) { bf16* rowp = P + (size_t)(row0 + ai * 128 + m * 16) * PA_LD + col0;
#pragma unroll
                    for (int bj = 0; bj < 2; ++bj) { pg8::f32x4 v0 = acc[ai][bj][m][0], v1 = acc[ai][bj][m][1];
                        if (sg) {
#pragma unroll
                            for (int j = 0; j < 4; ++j) { v0[j] = sigmoid_f(v0[j]); v1[j] = sigmoid_f(v1[j]); } }
                        v4u w; w.x = cvt_pk_bf16(v0[0], v0[1]); w.y = cvt_pk_bf16(v0[2], v0[3]); w.z = cvt_pk_bf16(v1[0], v1[1]); w.w = cvt_pk_bf16(v1[2], v1[3]);
                        *(v4u*)(rowp + bj * 128) = w; } }
        }
    }
};
struct EpiProjB {
    static constexpr bool PERM = true, AFTER_DRAIN = false; bf16* P; bf16* BG;
    __device__ __forceinline__ void operator()(const pg8::f32x4 (&acc)[2][2][4][2], const Unit& u, int wr, int wc, int fr, int fq) const {
        const int row0 = u.pm * 256 + wr * 64 + fr;
#pragma unroll
        for (int ai = 0; ai < 2; ++ai)
#pragma unroll
            for (int m = 0; m < 4; ++m) { const int row = row0 + ai * 128 + m * 16;
#pragma unroll
                for (int bj = 0; bj < 2; ++bj) { pg8::f32x4 v0 = acc[ai][bj][m][0], v1 = acc[ai][bj][m][1];
                    if (u.pn < 4) { bf16* p = P + (size_t)row * PA_LD + C_RV + u.pn * 256 + bj * 128 + wc * 32 + 8 * fq; const v4u r = *(const v4u*)p;
                        v4u w; w.x = cvt_pk_bf16(bflo(r.x) * silu_f(v0[0]), bfhi(r.x) * silu_f(v0[1])); w.y = cvt_pk_bf16(bflo(r.y) * silu_f(v0[2]), bfhi(r.y) * silu_f(v0[3]));
                        w.z = cvt_pk_bf16(bflo(r.z) * silu_f(v1[0]), bfhi(r.z) * silu_f(v1[1])); w.w = cvt_pk_bf16(bflo(r.w) * silu_f(v1[2]), bfhi(r.w) * silu_f(v1[3]));
                        *(v4u*)p = w;
                    } else { bf16* p = BG + (size_t)row * 2048 + (u.pn - 4) * 256 + bj * 128 + wc * 32 + 8 * fq;
                        v4u w; w.x = cvt_pk_bf16(sigmoid_f(v0[0]), sigmoid_f(v0[1])); w.y = cvt_pk_bf16(sigmoid_f(v0[2]), sigmoid_f(v0[3]));
                        w.z = cvt_pk_bf16(sigmoid_f(v1[0]), sigmoid_f(v1[1])); w.w = cvt_pk_bf16(sigmoid_f(v1[2]), sigmoid_f(v1[3]));
                        *(v4u*)p = w; } } }
    }
};
template <bool SECOND> struct EpiMerge {
    static constexpr bool PERM = true, AFTER_DRAIN = false; const bf16* BG; bf16* T1; bf16* OUT;
    __device__ __forceinline__ void operator()(const pg8::f32x4 (&acc)[2][2][4][2], const Unit& u, int wr, int wc, int fr, int fq) const {
        const int row0 = u.pm * 256 + wr * 64 + fr;
#pragma unroll
        for (int ai = 0; ai < 2; ++ai)
#pragma unroll
            for (int m = 0; m < 4; ++m) { const int row = row0 + ai * 128 + m * 16;
#pragma unroll
                for (int bj = 0; bj < 2; ++bj) { const int col = u.pn * 256 + bj * 128 + wc * 32 + 8 * fq; const pg8::f32x4 v0 = acc[ai][bj][m][0], v1 = acc[ai][bj][m][1];
                    const v4u g = *(const v4u*)(BG + (size_t)row * 2048 + (SECOND ? 1024 : 0) + col);
                    float o[8] = {bflo(g.x) * v0[0], bfhi(g.x) * v0[1], bflo(g.y) * v0[2], bfhi(g.y) * v0[3], bflo(g.z) * v1[0], bfhi(g.z) * v1[1], bflo(g.w) * v1[2], bfhi(g.w) * v1[3]};
                    if (SECOND) { const v4u t = *(const v4u*)(T1 + (size_t)row * D + col);
                        o[0] += bflo(t.x); o[1] += bfhi(t.x); o[2] += bflo(t.y); o[3] += bfhi(t.y); o[4] += bflo(t.z); o[5] += bfhi(t.z); o[6] += bflo(t.w); o[7] += bfhi(t.w); }
                    v4u w; w.x = cvt_pk_bf16(o[0], o[1]); w.y = cvt_pk_bf16(o[2], o[3]); w.z = cvt_pk_bf16(o[4], o[5]); w.w = cvt_pk_bf16(o[6], o[7]);
                    *(v4u*)((SECOND ? OUT : T1) + (size_t)row * D + col) = w; } }
    }
};

__device__ __forceinline__ void chunk_info(int gc, int& n, int& N) { if (gc < 32) { n = gc & 1; N = 2; } else { n = (gc - 32) & 7; N = 8; } }
__device__ __forceinline__ size_t st_idx(int gc, int h, int dir) { return (size_t)((gc * 4 + h) * 2 + dir); }

__device__ __forceinline__ float conv_silu(const bf16* PA, const float* cw, const float* cb, int row, int col, int ch, bool first, bool last) {
    const bf16* p = PA + (size_t)row * PA_LD + col;
    float y = cb[ch] + cw[1024 + ch] * bf2f(p[0]);
    if (!first) y += cw[ch] * bf2f(p[-PA_LD]);
    if (!last) y += cw[2048 + ch] * bf2f(p[PA_LD]);
    return silu_f(y);
}

__device__ __forceinline__ void p7_scalar(const Args& a, const Frame& F) {
    bf16* RS = (bf16*)(a.ws + WS_RS); bf16* MC = (bf16*)(a.ws + WS_MC); float* MN = (float*)(a.ws + WS_MN); float* MS = (float*)(a.ws + WS_MS);
    const int gt = F.bid * 512 + F.tid, ngt = F.G * 512;
    for (long e = gt; e < 24L * 4 * 2 * 32768; e += ngt) {
        const int idx = (int)(e & 32767), sh = (int)(e >> 15), dir = sh & 1, h = (sh >> 1) & 3, s = sh >> 3; const int ev = idx >> 7, d = idx & 127;
        const bool lat = s >= 16; const int N = lat ? 8 : 2, gc0 = lat ? 32 + 8 * (s - 16) : 2 * s;
        const float G = expf(128.f * logsigmoid_f(a.in[I_DECAY][dir * 4 + h]));
        float acc = lat ? a.in[I_SRET][((size_t)(((s - 16) * 2 + dir) * 4 + h)) * 32768 + d * 256 + ev] : 0.f;
        for (int st = 0; st < N; ++st) { const int n = dir ? N - 1 - st : st; bf16* p = RS + st_idx(gc0 + n, h, dir) * 32768 + idx; const float t = bf2f(*p); *p = (bf16)f2bf(acc); acc = G * acc + t; }
        if (!lat) a.out[OUT_SRET + ((size_t)((s * 2 + dir) * 4 + h)) * 32768 + d * 256 + ev] = acc;
    }
    for (long e = gt; e < 24L * 4 * 2 * 16384; e += ngt) {
        const int idx = (int)(e & 16383), sh = (int)(e >> 14), dir = sh & 1, h = (sh >> 1) & 3, s = sh >> 3;
        const bool lat = s >= 16; const int N = lat ? 8 : 2, gc0 = lat ? 32 + 8 * (s - 16) : 2 * s; const int sidx = lat ? ((s - 16) * 2 + dir) * 4 + h : 0;
        float m = lat ? a.in[I_SM][sidx] : 0.f; float C = lat ? a.in[I_SC][(size_t)sidx * 16384 + idx] : 0.f; float nv = (lat && idx < 128) ? a.in[I_SN][sidx * 128 + idx] : 0.f;
        for (int st = 0; st < N; ++st) { const int n = dir ? N - 1 - st : st; const size_t si = st_idx(gc0 + n, h, dir);
            const float ml = MS[si * 4 + 0], bl = MS[si * 4 + 1]; const float mn = fmaxf(bl + m, ml), a1 = expf(bl + m - mn), a2 = expf(ml - mn);
            bf16* p = MC + si * 16384 + idx; const float t = bf2f(*p); *p = (bf16)f2bf(C); C = a1 * C + a2 * t;
            if (idx < 128) { float* q = MN + si * 128 + idx; const float tn = *q; *q = nv; nv = a1 * nv + a2 * tn; }
            if (idx == 0) MS[si * 4 + 2] = m;
            m = mn; }
        if (!lat) { const int o = (s * 2 + dir) * 4 + h; a.out[OUT_SC + (size_t)o * 16384 + idx] = C; if (idx < 128) a.out[OUT_SN + o * 128 + idx] = nv; if (idx == 0) a.out[OUT_SM + o] = m; }
    }
}


typedef short bf16x8 __attribute__((ext_vector_type(8)));
typedef short s16x4 __attribute__((ext_vector_type(4)));
#define MFMA16(a, b, c) __builtin_amdgcn_mfma_f32_16x16x32_bf16(a, b, c, 0, 0, 0)
constexpr float KSCALE = 0.08838834764831845f;
constexpr int LQ = 136, LV = 264;

__device__ __forceinline__ bf16x8 frag_row(const LAS bf16* T, int LD, int r0, int k0, int lane) { return *(const LAS bf16x8*)(T + (r0 + (lane & 15)) * LD + k0 + 8 * (lane >> 4)); }
__device__ __forceinline__ bf16x8 frag_row_g(const bf16* T, int LD, int r0, int k0, int lane) { return *(const bf16x8*)(T + (size_t)(r0 + (lane & 15)) * LD + k0 + 8 * (lane >> 4)); }
__device__ __forceinline__ bf16x8 frag_tr(const LAS bf16* T, int LD, int k0, int n0, int lane) {
    const LAS bf16* p = T + (k0 + 8 * (lane >> 4) + ((lane & 15) >> 2)) * LD + n0 + 4 * (lane & 3);
    const s16x4 lo = __builtin_amdgcn_ds_read_tr16_b64_v4i16((LAS s16x4*)p), hi = __builtin_amdgcn_ds_read_tr16_b64_v4i16((LAS s16x4*)(p + 4 * LD));
    return (bf16x8){lo[0], lo[1], lo[2], lo[3], hi[0], hi[1], hi[2], hi[3]};
}
__device__ __forceinline__ void unpack8(const v4u v, float (&f)[8]) { f[0] = bflo(v.x); f[1] = bfhi(v.x); f[2] = bflo(v.y); f[3] = bfhi(v.y); f[4] = bflo(v.z); f[5] = bfhi(v.z); f[6] = bflo(v.w); f[7] = bfhi(v.w); }
__device__ __forceinline__ v4u pack8(const float (&f)[8]) { v4u w; w.x = pk2(f[0], f[1]); w.y = pk2(f[2], f[3]); w.z = pk2(f[4], f[5]); w.w = pk2(f[6], f[7]); return w; }
template <int W, int LD> __device__ __forceinline__ void stage_tile(LAS bf16* T, const bf16* src, int ld_src, int tid) {
    constexpr int CPR = W / 8, NIT = 128 * CPR / 512; v4u t[NIT];
#pragma unroll
    for (int i = 0; i < NIT; ++i) { const int c = tid + 512 * i, r = c / CPR, cc = c % CPR; t[i] = *(const v4u*)(src + (size_t)r * ld_src + cc * 8); }
#pragma unroll
    for (int i = 0; i < NIT; ++i) { const int c = tid + 512 * i, r = c / CPR, cc = c % CPR; *(LAS v4u*)(T + r * LD + cc * 8) = t[i]; }
}
struct ConvW { float w0[8], w1[8], w2[8], b[8]; };
__device__ __forceinline__ void conv_load(ConvW& c, const float* cw, const float* cb, int ch) {
#pragma unroll
    for (int i = 0; i < 8; ++i) { c.w0[i] = cw[ch + i]; c.w1[i] = cw[1024 + ch + i]; c.w2[i] = cw[2048 + ch + i]; c.b[i] = cb[ch + i]; }
}
__device__ __forceinline__ void conv_chunk(const ConvW& c, const bf16* p, bool first, bool last, float scale, float (&y)[8]) {
    const v4u z = {0u, 0u, 0u, 0u}; const v4u x0 = *(const v4u*)p, xm = first ? z : *(const v4u*)(p - PA_LD), xp = last ? z : *(const v4u*)(p + PA_LD);
    float f0[8], fm[8], fp[8]; unpack8(x0, f0); unpack8(xm, fm); unpack8(xp, fp);
#pragma unroll
    for (int i = 0; i < 8; ++i) y[i] = silu_f(c.b[i] + c.w0[i] * fm[i] + c.w1[i] * f0[i] + c.w2[i] * fp[i]) * scale;
}


__device__ __forceinline__ float gate_scan(const LAS float* lfd, const LAS float* igd, LAS float* bd, int dir, int lane, float& pm0, float& pm1, int& j0, int& j1, float& b0, float& b1) {
    j0 = dir ? 127 - 2 * lane : 2 * lane; j1 = dir ? 126 - 2 * lane : 2 * lane + 1;
    const float x0 = lfd[j0], x1 = lfd[j1], s1 = x0 + x1; float incl = s1;
#pragma unroll
    for (int o = 1; o < 64; o <<= 1) { const float t = __shfl_up(incl, o); if (lane >= o) incl += t; }
    const float excl = incl - s1; b0 = excl + x0; b1 = excl + s1; bd[j0] = b0; bd[j1] = b1;
    const float y0 = igd[j0] - b0, y1 = igd[j1] - b1, m1 = fmaxf(y0, y1); float pmx = m1;
#pragma unroll
    for (int o = 1; o < 64; o <<= 1) { const float t = __shfl_up(pmx, o); if (lane >= o) pmx = fmaxf(pmx, t); }
    float pex = __shfl_up(pmx, 1); if (lane == 0) pex = -3.0e38f;
    pm0 = fmaxf(pex, y0); pm1 = fmaxf(pex, m1);
    return __shfl(incl, 63);
}

__device__ __forceinline__ void p6_mfma(const Args& a, int tid_in, int bid, int G, LAS unsigned char* L) {
    const bf16* PA = (const bf16*)(a.ws + WS_PA); bf16* RS = (bf16*)(a.ws + WS_RS); bf16* MC = (bf16*)(a.ws + WS_MC);
    float* MN = (float*)(a.ws + WS_MN); float* MS = (float*)(a.ws + WS_MS);
    const float* IG = (const float*)(a.ws + WS_IG); const float* LF = (const float*)(a.ws + WS_LF);
    for (int it = bid; it < 2 * NCHUNK * 4; it += G) {
        int tid = tid_in; asm volatile("" : "+v"(tid));
        const int lane = tid & 63, wave = __builtin_amdgcn_readfirstlane(tid >> 6);
        const int branch = it / (NCHUNK * 4), gc = (it % (NCHUNK * 4)) >> 2, h = it & 3, row0 = gc * CH; int n, N; chunk_info(gc, n, N);
        __syncthreads();
        if (branch == 0) {
            LAS bf16* V_l = (LAS bf16*)L; LAS bf16* Kf = (LAS bf16*)(L + 67584); LAS bf16* Kb = (LAS bf16*)(L + 67584 + 34816);
            const float lg0 = logsigmoid_f(a.in[I_DECAY][h]), lg1 = logsigmoid_f(a.in[I_DECAY][4 + h]);
            stage_tile<256, LV>(V_l, PA + (size_t)row0 * PA_LD + C_RV + h * 256, PA_LD, tid);
            for (int c = tid; c < 128 * 16; c += 512) { const int j = c >> 4, cc = c & 15; float f[8], g[8];
                unpack8(*(const v4u*)(PA + (size_t)(row0 + j) * PA_LD + C_RK + h * 128 + cc * 8), f);
                const float wf = __expf(lg0 * (float)(127 - j)), wb = __expf(lg1 * (float)j);
#pragma unroll
                for (int i = 0; i < 8; ++i) { g[i] = f[i] * wb; f[i] *= wf; }
                *(LAS v4u*)(Kf + j * LQ + cc * 8) = pack8(f); *(LAS v4u*)(Kb + j * LQ + cc * 8) = pack8(g); }
            __syncthreads();
#pragma unroll 1
            for (int dir = 0; dir < 2; ++dir) { const LAS bf16* Kd = dir ? Kb : Kf; pg8::f32x4 acc[2][8];
#pragma unroll
                for (int m = 0; m < 2; ++m)
#pragma unroll
                    for (int nn = 0; nn < 8; ++nn) acc[m][nn] = (pg8::f32x4){0.f, 0.f, 0.f, 0.f};
#pragma unroll 1
                for (int k0 = 0; k0 < 128; k0 += 32) { bf16x8 af[2];
#pragma unroll
                    for (int m = 0; m < 2; ++m) af[m] = frag_tr(V_l, LV, k0, wave * 32 + m * 16, lane);
#pragma unroll
                    for (int nn = 0; nn < 8; ++nn) { const bf16x8 bfr = frag_tr(Kd, LQ, k0, nn * 16, lane);
#pragma unroll
                        for (int m = 0; m < 2; ++m) acc[m][nn] = MFMA16(bfr, af[m], acc[m][nn]); } }
                bf16* out = RS + st_idx(gc, h, dir) * 32768;
#pragma unroll
                for (int m = 0; m < 2; ++m)
#pragma unroll
                    for (int nn = 0; nn < 8; ++nn) { v2u w; w.x = cvt_pk_bf16(acc[m][nn][0], acc[m][nn][1]); w.y = cvt_pk_bf16(acc[m][nn][2], acc[m][nn][3]);
                        *(v2u*)(out + (wave * 32 + m * 16 + (lane & 15)) * 128 + nn * 16 + 4 * (lane >> 4)) = w; }
            }
        } else {
            LAS bf16* V_l = (LAS bf16*)L; LAS bf16* Kf = (LAS bf16*)(L + 34816); LAS bf16* Kb = (LAS bf16*)(L + 2 * 34816);
            LAS float* sml = (LAS float*)(L + 3 * 34816); LAS float* lfs = sml; LAS float* igs = sml + 256; LAS float* bs = sml + 512; LAS float* ws_ = sml + 768;
            stage_tile<128, LQ>(V_l, PA + (size_t)row0 * PA_LD + C_MV + h * 128, PA_LD, tid);
            if (tid < 256) { const int dir = tid >> 7, j = tid & 127; lfs[tid] = LF[(size_t)(row0 + j) * 8 + dir * 4 + h]; igs[tid] = IG[(size_t)(row0 + j) * 8 + dir * 4 + h]; }
            __syncthreads();
            if (wave < 2) { const int dir = wave; float pm0, pm1, b0, b1; int j0, j1;
                const float blast = gate_scan(lfs + dir * 128, igs + dir * 128, bs + dir * 128, dir, lane, pm0, pm1, j0, j1, b0, b1);
                const float g0 = blast - b0 + igs[dir * 128 + j0], g1 = blast - b1 + igs[dir * 128 + j1]; float ml = fmaxf(g0, g1);
#pragma unroll
                for (int o = 1; o < 64; o <<= 1) ml = fmaxf(ml, __shfl_xor(ml, o));
                ws_[dir * 128 + j0] = expf(g0 - ml); ws_[dir * 128 + j1] = expf(g1 - ml);
                if (lane == 0) { MS[st_idx(gc, h, dir) * 4 + 0] = ml; MS[st_idx(gc, h, dir) * 4 + 1] = blast; } }
            __syncthreads();
            { ConvW cwv; const int cc = tid & 15; conv_load(cwv, a.in[I_CONVW], a.in[I_CONVB], 512 + h * 128 + cc * 8);
              for (int c = tid; c < 128 * 16; c += 512) { const int j = c >> 4; float f[8], g[8];
                  conv_chunk(cwv, PA + (size_t)(row0 + j) * PA_LD + C_MK + h * 128 + cc * 8, n == 0 && j == 0, n == N - 1 && j == 127, KSCALE, f);
                  const float wf = ws_[j], wb = ws_[128 + j];
#pragma unroll
                  for (int i = 0; i < 8; ++i) { const float kq = bf2f((bf16)f2bf(f[i])); g[i] = kq * wb; f[i] = kq * wf; }
                  *(LAS v4u*)(Kf + j * LQ + cc * 8) = pack8(f); *(LAS v4u*)(Kb + j * LQ + cc * 8) = pack8(g); } }
            __syncthreads();
            if (tid < 256) { const int dir = tid >> 7, k = tid & 127; const LAS bf16* Kd = dir ? Kb : Kf; float s = 0.f;
#pragma unroll 16
                for (int j = 0; j < 128; ++j) s += bf2f(Kd[j * LQ + k]);
                MN[st_idx(gc, h, dir) * 128 + k] = s; }
#pragma unroll 1
            for (int dir = 0; dir < 2; ++dir) { const LAS bf16* Kd = dir ? Kb : Kf; pg8::f32x4 acc[8];
#pragma unroll
                for (int nn = 0; nn < 8; ++nn) acc[nn] = (pg8::f32x4){0.f, 0.f, 0.f, 0.f};
#pragma unroll 1
                for (int k0 = 0; k0 < 128; k0 += 32) { const bf16x8 af = frag_tr(V_l, LQ, k0, wave * 16, lane);
#pragma unroll
                    for (int nn = 0; nn < 8; ++nn) { const bf16x8 bfr = frag_tr(Kd, LQ, k0, nn * 16, lane); acc[nn] = MFMA16(bfr, af, acc[nn]); } }
                bf16* out = MC + st_idx(gc, h, dir) * 16384;
#pragma unroll
                for (int nn = 0; nn < 8; ++nn) { v2u w; w.x = cvt_pk_bf16(acc[nn][0], acc[nn][1]); w.y = cvt_pk_bf16(acc[nn][2], acc[nn][3]);
                    *(v2u*)(out + (wave * 16 + (lane & 15)) * 128 + nn * 16 + 4 * (lane >> 4)) = w; }
            }
        }
    }
}

template <int MODE> __device__ __forceinline__ void p8_mfma(const Args& a, int tid_in, int bid, int G, LAS unsigned char* L) {
    bf16* PA = (bf16*)(a.ws + WS_PA); const bf16* RS = (const bf16*)(a.ws + WS_RS); const bf16* MC = (const bf16*)(a.ws + WS_MC);
    const float* MN = (const float*)(a.ws + WS_MN); const float* MS = (const float*)(a.ws + WS_MS);
    const float* IG = (const float*)(a.ws + WS_IG); const float* LF = (const float*)(a.ws + WS_LF);
    LAS bf16* Q_l = (LAS bf16*)L; LAS bf16* K_l = (LAS bf16*)(L + 34816); LAS bf16* P_l = K_l; LAS bf16* V_l = (LAS bf16*)(L + 2 * 34816);
    for (int it = bid; it < 2 * NCHUNK * 4; it += G) {
        int tid = tid_in; asm volatile("" : "+v"(tid));
        const int lane = tid & 63, wave = __builtin_amdgcn_readfirstlane(tid >> 6), fr = lane & 15, fq = lane >> 4;
        const int branch = it / (NCHUNK * 4), gc = (it % (NCHUNK * 4)) >> 2, h = it & 3, row0 = gc * CH; int n, N; chunk_info(gc, n, N);
        const bool lat = gc >= 32;
        if (!(MODE & (branch ? 2 : 1))) continue;
        __syncthreads();
        if (branch == 0) {
            LAS float* red = (LAS float*)(L + 2 * 34816 + 67584);
            const float lg0 = logsigmoid_f(a.in[I_DECAY][h]), lg1 = logsigmoid_f(a.in[I_DECAY][4 + h]);
            const bool hasf = lat || n > 0, hasb = lat || n < N - 1;
            bf16x8 sfr[2][4][2];
#pragma unroll
            for (int dir = 0; dir < 2; ++dir) { const bf16* S = RS + st_idx(gc, h, dir) * 32768;
                if (dir ? hasb : hasf) {
#pragma unroll
                    for (int ks = 0; ks < 4; ++ks) { sfr[dir][ks][0] = frag_row_g(S, 128, wave * 32, ks * 32, lane); sfr[dir][ks][1] = frag_row_g(S, 128, wave * 32 + 16, ks * 32, lane); } }
                else {
#pragma unroll
                    for (int ks = 0; ks < 4; ++ks) { sfr[dir][ks][0] = (bf16x8){0, 0, 0, 0, 0, 0, 0, 0}; sfr[dir][ks][1] = sfr[dir][ks][0]; } } }
            stage_tile<128, LQ>(Q_l, PA + (size_t)row0 * PA_LD + C_RQ + h * 128, PA_LD, tid);
            stage_tile<128, LQ>(K_l, PA + (size_t)row0 * PA_LD + C_RK + h * 128, PA_LD, tid);
            stage_tile<256, LV>(V_l, PA + (size_t)row0 * PA_LD + C_RV + h * 256, PA_LD, tid);
            __syncthreads();
            {
                pg8::f32x4 sc[8];
#pragma unroll
                for (int m = 0; m < 8; ++m) sc[m] = (pg8::f32x4){0.f, 0.f, 0.f, 0.f};
#pragma unroll 1
                for (int k0 = 0; k0 < 128; k0 += 32) { const bf16x8 bfr = frag_row(K_l, LQ, wave * 16, k0, lane);
#pragma unroll
                    for (int m = 0; m < 8; ++m) sc[m] = MFMA16(bfr, frag_row(Q_l, LQ, m * 16, k0, lane), sc[m]); }
                __syncthreads();
#pragma unroll
                for (int m = 0; m < 8; ++m) { const int i = m * 16 + fr; float p[4];
#pragma unroll
                    for (int r = 0; r < 4; ++r) { const int j = wave * 16 + 4 * fq + r; const float dm = i > j ? __expf(lg0 * (float)(i - j)) : (i < j ? __expf(lg1 * (float)(j - i)) : 2.f); p[r] = sc[m][r] * dm; }
                    v2u w; w.x = cvt_pk_bf16(p[0], p[1]); w.y = cvt_pk_bf16(p[2], p[3]); *(LAS v2u*)(P_l + i * LQ + wave * 16 + 4 * fq) = w; }
            }
            __syncthreads();
            pg8::f32x4 accR[8][2];
#pragma unroll
            for (int m = 0; m < 8; ++m) { accR[m][0] = (pg8::f32x4){0.f, 0.f, 0.f, 0.f}; accR[m][1] = (pg8::f32x4){0.f, 0.f, 0.f, 0.f}; }
#pragma unroll
            for (int dir = 0; dir < 2; ++dir) {
                if (!(dir ? hasb : hasf)) continue;
#pragma unroll
                for (int ks = 0; ks < 4; ++ks) {
#pragma unroll
                    for (int m = 0; m < 8; ++m) { const bf16x8 af = frag_row(Q_l, LQ, m * 16, ks * 32, lane); accR[m][0] = MFMA16(sfr[dir][ks][0], af, accR[m][0]); accR[m][1] = MFMA16(sfr[dir][ks][1], af, accR[m][1]); } }
#pragma unroll
                for (int m = 0; m < 8; ++m) { const float i = (float)(m * 16 + fr); const float ef = lg0 * (i + 1.f), eb = lg1 * (128.f - i);
                    const float wq = dir ? __expf(eb) : (hasb ? __expf(ef - eb) : __expf(ef));
                    accR[m][0] *= wq; accR[m][1] *= wq; }
            }
#pragma unroll 1
            for (int k0 = 0; k0 < 128; k0 += 32) { const bf16x8 b0 = frag_tr(V_l, LV, k0, wave * 32, lane), b1 = frag_tr(V_l, LV, k0, wave * 32 + 16, lane);
#pragma unroll
                for (int m = 0; m < 8; ++m) { const bf16x8 af = frag_row(P_l, LQ, m * 16, k0, lane); accR[m][0] = MFMA16(b0, af, accR[m][0]); accR[m][1] = MFMA16(b1, af, accR[m][1]); } }
#pragma unroll
            for (int m = 0; m < 8; ++m) { float s1 = 0.f, s2 = 0.f;
#pragma unroll
                for (int nn = 0; nn < 2; ++nn)
#pragma unroll
                    for (int r = 0; r < 4; ++r) { const float x = accR[m][nn][r]; s1 += x; s2 += x * x; }
                s1 += __shfl_xor(s1, 16); s1 += __shfl_xor(s1, 32); s2 += __shfl_xor(s2, 16); s2 += __shfl_xor(s2, 32);
                if (fq == 0) { red[((m * 16 + fr) * 8 + wave) * 2] = s1; red[((m * 16 + fr) * 8 + wave) * 2 + 1] = s2; } }
            __syncthreads();
            pg8::f32x4 gnv[2];
#pragma unroll
            for (int nn = 0; nn < 2; ++nn) gnv[nn] = *(const pg8::f32x4*)(a.in[I_RETGN] + h * 256 + wave * 32 + nn * 16 + 4 * fq);
#pragma unroll
            for (int m = 0; m < 8; ++m) { const int i = m * 16 + fr; float s1 = 0.f, s2 = 0.f;
#pragma unroll
                for (int w = 0; w < 8; ++w) { s1 += red[(i * 8 + w) * 2]; s2 += red[(i * 8 + w) * 2 + 1]; }
                const float mu = s1 * (1.f / 256.f), rstd = 1.f / sqrtf(fmaxf(s2 * (1.f / 256.f) - mu * mu, 0.f) + EPS_GN);
#pragma unroll
                for (int nn = 0; nn < 2; ++nn) { const pg8::f32x4 y = (accR[m][nn] - mu) * rstd * gnv[nn]; v2u w; w.x = cvt_pk_bf16(y[0], y[1]); w.y = cvt_pk_bf16(y[2], y[3]);
                    *(v2u*)(PA + (size_t)(row0 + i) * PA_LD + C_RV + h * 256 + wave * 32 + nn * 16 + 4 * fq) = w; } }
        } else {
            LAS bf16* Vm = (LAS bf16*)(L + 2 * 34816);
            LAS float* sml = (LAS float*)(L + 3 * 34816);
            LAS float* lfs = sml; LAS float* igs = sml + 256; LAS float* bs = sml + 512; LAS float* mis = sml + 768; LAS float* wis = sml + 1024; LAS float* qns = sml + 1280; LAS float* rds = sml + 1536; LAS float* nps = sml + 1792;
            LAS float* red = sml + 2048;
            const size_t si0 = st_idx(gc, h, 0);
            const bool hasf = lat || n > 0, hasb = lat || n < N - 1;
            bf16x8 cfr[2][4];
#pragma unroll
            for (int dir = 0; dir < 2; ++dir) { const bf16* Cp = MC + (si0 + dir) * 16384;
                if (dir ? hasb : hasf) {
#pragma unroll
                    for (int ks = 0; ks < 4; ++ks) cfr[dir][ks] = frag_row_g(Cp, 128, wave * 16, ks * 32, lane); }
                else {
#pragma unroll
                    for (int ks = 0; ks < 4; ++ks) cfr[dir][ks] = (bf16x8){0, 0, 0, 0, 0, 0, 0, 0}; } }
            {   ConvW cq, ck; const int cc = tid & 15; conv_load(cq, a.in[I_CONVW], a.in[I_CONVB], h * 128 + cc * 8); conv_load(ck, a.in[I_CONVW], a.in[I_CONVB], 512 + h * 128 + cc * 8);
                for (int c = tid; c < 128 * 16; c += 512) { const int j = c >> 4; const bool fi = n == 0 && j == 0, la = n == N - 1 && j == 127; float f[8];
                    conv_chunk(cq, PA + (size_t)(row0 + j) * PA_LD + C_MQ + h * 128 + cc * 8, fi, la, 1.f, f); *(LAS v4u*)(Q_l + j * LQ + cc * 8) = pack8(f);
                    conv_chunk(ck, PA + (size_t)(row0 + j) * PA_LD + C_MK + h * 128 + cc * 8, fi, la, KSCALE, f); *(LAS v4u*)(K_l + j * LQ + cc * 8) = pack8(f); } }
            stage_tile<128, LQ>(Vm, PA + (size_t)row0 * PA_LD + C_MV + h * 128, PA_LD, tid);
            if (tid < 256) { const int dir = tid >> 7, j = tid & 127; lfs[tid] = LF[(size_t)(row0 + j) * 8 + dir * 4 + h]; igs[tid] = IG[(size_t)(row0 + j) * 8 + dir * 4 + h]; nps[tid] = MN[(si0 + dir) * 128 + j]; }
            __syncthreads();
            if (wave < 2) { const int dir = wave; float pm0, pm1, b0, b1; int j0, j1;
                (void)gate_scan(lfs + dir * 128, igs + dir * 128, bs + dir * 128, dir, lane, pm0, pm1, j0, j1, b0, b1);
                const float mprev = MS[(si0 + dir) * 4 + 2];
                { const float lin = b0 + mprev, mi = fmaxf(b0 + pm0, lin); mis[dir * 128 + j0] = mi; wis[dir * 128 + j0] = expf(lin - mi); }
                { const float lin = b1 + mprev, mi = fmaxf(b1 + pm1, lin); mis[dir * 128 + j1] = mi; wis[dir * 128 + j1] = expf(lin - mi); } }
            {
                const int i = tid & 127, qq = tid >> 7; float q0 = 0.f, q1 = 0.f;
#pragma unroll
                for (int kk = 0; kk < 16; ++kk) { const unsigned w = *(const LAS unsigned*)(Q_l + i * LQ + 32 * qq + 2 * kk); const float x = bflo(w), y = bfhi(w); const int k = 32 * qq + 2 * kk;
                    q0 += x * nps[k] + y * nps[k + 1]; q1 += x * nps[128 + k] + y * nps[128 + k + 1]; }
                red[(qq * 2 + 0) * 128 + i] = q0; red[(qq * 2 + 1) * 128 + i] = q1; }
            __syncthreads();
            if (tid < 256) { const int dir = tid >> 7, i = tid & 127; qns[tid] = (red[dir * 128 + i] + red[(2 + dir) * 128 + i]) + (red[(4 + dir) * 128 + i] + red[(6 + dir) * 128 + i]); }
            __syncthreads();
            {
                pg8::f32x4 sc[8];
#pragma unroll
                for (int m = 0; m < 8; ++m) sc[m] = (pg8::f32x4){0.f, 0.f, 0.f, 0.f};
#pragma unroll 1
                for (int k0 = 0; k0 < 128; k0 += 32) { const bf16x8 bfr = frag_row(K_l, LQ, wave * 16, k0, lane);
#pragma unroll
                    for (int m = 0; m < 8; ++m) sc[m] = MFMA16(bfr, frag_row(Q_l, LQ, m * 16, k0, lane), sc[m]); }
                pg8::f32x4 s0[8], s1[8];
#pragma unroll
                for (int m = 0; m < 8; ++m) { const int i = m * 16 + fr; const float e0 = bs[i] - mis[i], e1 = bs[128 + i] - mis[128 + i]; float r0 = 0.f, r1 = 0.f;
#pragma unroll
                    for (int r = 0; r < 4; ++r) { const int j = wave * 16 + 4 * fq + r;
                        s0[m][r] = j <= i ? sc[m][r] * __expf(e0 - bs[j] + igs[j]) : 0.f; s1[m][r] = j >= i ? sc[m][r] * __expf(e1 - bs[128 + j] + igs[128 + j]) : 0.f;
                        r0 += s0[m][r]; r1 += s1[m][r]; }
                    r0 += __shfl_xor(r0, 16); r0 += __shfl_xor(r0, 32); r1 += __shfl_xor(r1, 16); r1 += __shfl_xor(r1, 32);
                    if (fq == 0) { red[i * 8 + wave] = r0; red[(128 + i) * 8 + wave] = r1; } }
                __syncthreads();
                if (tid < 256) { float den = 0.f;
#pragma unroll
                    for (int w = 0; w < 8; ++w) den += red[tid * 8 + w];
                    den += wis[tid] * qns[tid]; rds[tid] = 1.f / fmaxf(fabsf(den), expf(-mis[tid])); }
                __syncthreads();
#pragma unroll
                for (int m = 0; m < 8; ++m) { const int i = m * 16 + fr; const float d0 = rds[i], d1 = rds[128 + i];
                    const pg8::f32x4 p = s0[m] * d0 + s1[m] * d1; v2u w; w.x = cvt_pk_bf16(p[0], p[1]); w.y = cvt_pk_bf16(p[2], p[3]); *(LAS v2u*)(P_l + i * LQ + wave * 16 + 4 * fq) = w; }
            }
            __syncthreads();
            pg8::f32x4 accH[8];
#pragma unroll
            for (int m = 0; m < 8; ++m) accH[m] = (pg8::f32x4){0.f, 0.f, 0.f, 0.f};
#pragma unroll
            for (int dir = 0; dir < 2; ++dir) {
                if (!(dir ? hasb : hasf)) continue;
                pg8::f32x4 accX[8];
#pragma unroll
                for (int m = 0; m < 8; ++m) accX[m] = (pg8::f32x4){0.f, 0.f, 0.f, 0.f};
#pragma unroll
                for (int ks = 0; ks < 4; ++ks) {
#pragma unroll
                    for (int m = 0; m < 8; ++m) accX[m] = MFMA16(cfr[dir][ks], frag_row(Q_l, LQ, m * 16, ks * 32, lane), accX[m]); }
#pragma unroll
                for (int m = 0; m < 8; ++m) { const int i = dir * 128 + m * 16 + fr; accH[m] += accX[m] * (wis[i] * rds[i]); }
            }
#pragma unroll 1
            for (int k0 = 0; k0 < 128; k0 += 32) { const bf16x8 bfr = frag_tr(Vm, LQ, k0, wave * 16, lane);
#pragma unroll
                for (int m = 0; m < 8; ++m) accH[m] = MFMA16(bfr, frag_row(P_l, LQ, m * 16, k0, lane), accH[m]); }
            __syncthreads();
#pragma unroll
            for (int m = 0; m < 8; ++m) { const int i = m * 16 + fr; const v2u g = *(const v2u*)(PA + (size_t)(row0 + i) * PA_LD + C_MO + h * 128 + wave * 16 + 4 * fq);
                accH[m][0] *= bflo(g.x); accH[m][1] *= bfhi(g.x); accH[m][2] *= bflo(g.y); accH[m][3] *= bfhi(g.y);
                float s1 = (accH[m][0] + accH[m][1]) + (accH[m][2] + accH[m][3]), s2 = (accH[m][0] * accH[m][0] + accH[m][1] * accH[m][1]) + (accH[m][2] * accH[m][2] + accH[m][3] * accH[m][3]);
                s1 += __shfl_xor(s1, 16); s1 += __shfl_xor(s1, 32); s2 += __shfl_xor(s2, 16); s2 += __shfl_xor(s2, 32);
                if (fq == 0) { red[(i * 8 + wave) * 2] = s1; red[(i * 8 + wave) * 2 + 1] = s2; } }
            __syncthreads();
            const pg8::f32x4 gnv = *(const pg8::f32x4*)(a.in[I_MGN] + h * 128 + wave * 16 + 4 * fq);
#pragma unroll
            for (int m = 0; m < 8; ++m) { const int i = m * 16 + fr; float s1 = 0.f, s2 = 0.f;
#pragma unroll
                for (int w = 0; w < 8; ++w) { s1 += red[(i * 8 + w) * 2]; s2 += red[(i * 8 + w) * 2 + 1]; }
                const float mu = s1 * (1.f / 128.f), rstd = 1.f / sqrtf(fmaxf(s2 * (1.f / 128.f) - mu * mu, 0.f) + EPS_GN);
                const pg8::f32x4 y = (accH[m] - mu) * rstd * gnv; v2u w; w.x = cvt_pk_bf16(y[0], y[1]); w.y = cvt_pk_bf16(y[2], y[3]);
                *(v2u*)(PA + (size_t)(row0 + i) * PA_LD + C_MV + h * 128 + wave * 16 + 4 * fq) = w; }
        }
    }
}

template <int N> __device__ __forceinline__ void scan_ret(bf16* RS, int gc0, int h, int dir, int tile, const float* init, float* fin, float Gd, int lane) {
    const int eb = tile >> 2, db = tile & 3, e0 = 64 * eb + 4 * (lane & 15), d0 = 32 * db + 8 * (lane >> 4);
    float acc[4][8];
#pragma unroll
    for (int dd = 0; dd < 8; ++dd) { pg8::f32x4 v = {0.f, 0.f, 0.f, 0.f}; if (init) v = *(const pg8::f32x4*)(init + (d0 + dd) * 256 + e0); acc[0][dd] = v[0]; acc[1][dd] = v[1]; acc[2][dd] = v[2]; acc[3][dd] = v[3]; }
#pragma unroll
    for (int st = 0; st < N; ++st) { const int n = dir ? N - 1 - st : st; bf16* p = RS + st_idx(gc0 + n, h, dir) * 32768 + e0 * 128 + d0;
        v4u t[4];
#pragma unroll
        for (int ee = 0; ee < 4; ++ee) t[ee] = *(const v4u*)(p + ee * 128);
#pragma unroll
        for (int ee = 0; ee < 4; ++ee) { float f[8]; unpack8(t[ee], f); *(v4u*)(p + ee * 128) = pack8(acc[ee]);
#pragma unroll
            for (int dd = 0; dd < 8; ++dd) acc[ee][dd] = Gd * acc[ee][dd] + f[dd]; } }
    if (fin) {
#pragma unroll
        for (int dd = 0; dd < 8; ++dd) *(pg8::f32x4*)(fin + (d0 + dd) * 256 + e0) = (pg8::f32x4){acc[0][dd], acc[1][dd], acc[2][dd], acc[3][dd]}; }
}
template <int N> __device__ __forceinline__ void scan_ml(bf16* MC, float* MN, float* MS, int gc0, int h, int dir, int vb, const float* iC, const float* in_, float m, float* fC, float* fn, float* fm, int lane) {
    const int row0 = 16 * vb + (lane >> 4), kc = 8 * (lane & 15);
    float C[4][8], nv0 = 0.f, nv1 = 0.f;
#pragma unroll
    for (int r = 0; r < 4; ++r) { pg8::f32x4 v0 = {0.f, 0.f, 0.f, 0.f}, v1 = v0; if (iC) { v0 = *(const pg8::f32x4*)(iC + (row0 + 4 * r) * 128 + kc); v1 = *(const pg8::f32x4*)(iC + (row0 + 4 * r) * 128 + kc + 4); }
#pragma unroll
        for (int i = 0; i < 4; ++i) { C[r][i] = v0[i]; C[r][4 + i] = v1[i]; } }
    if (vb == 0 && in_) { nv0 = in_[lane]; nv1 = in_[lane + 64]; }
#pragma unroll
    for (int st = 0; st < N; ++st) { const int n = dir ? N - 1 - st : st; const size_t si = st_idx(gc0 + n, h, dir);
        const float ml = MS[si * 4 + 0], bl = MS[si * 4 + 1]; const float mn = fmaxf(bl + m, ml), a1 = expf(bl + m - mn), a2 = expf(ml - mn);
        bf16* p = MC + si * 16384 + row0 * 128 + kc; v4u t[4];
#pragma unroll
        for (int r = 0; r < 4; ++r) t[r] = *(const v4u*)(p + 4 * r * 128);
#pragma unroll
        for (int r = 0; r < 4; ++r) { float f[8]; unpack8(t[r], f); *(v4u*)(p + 4 * r * 128) = pack8(C[r]);
#pragma unroll
            for (int i = 0; i < 8; ++i) C[r][i] = a1 * C[r][i] + a2 * f[i]; }
        if (vb == 0) { float* q = MN + si * 128; const float t0 = q[lane], t1 = q[lane + 64]; q[lane] = nv0; q[lane + 64] = nv1; nv0 = a1 * nv0 + a2 * t0; nv1 = a1 * nv1 + a2 * t1;
            if (lane == 0) MS[si * 4 + 2] = m; }
        m = mn; }
    if (fC) {
#pragma unroll
        for (int r = 0; r < 4; ++r) { *(pg8::f32x4*)(fC + (row0 + 4 * r) * 128 + kc) = (pg8::f32x4){C[r][0], C[r][1], C[r][2], C[r][3]}; *(pg8::f32x4*)(fC + (row0 + 4 * r) * 128 + kc + 4) = (pg8::f32x4){C[r][4], C[r][5], C[r][6], C[r][7]}; }
        if (vb == 0) { fn[lane] = nv0; fn[lane + 64] = nv1; if (lane == 0) *fm = m; } }
}
__device__ __forceinline__ void p7_scan(const Args& a, int tid_in, int bid, int G) {
    bf16* RS = (bf16*)(a.ws + WS_RS); bf16* MC = (bf16*)(a.ws + WS_MC); float* MN = (float*)(a.ws + WS_MN); float* MS = (float*)(a.ws + WS_MS);
    int tid = tid_in; asm volatile("" : "+v"(tid));
    const int lane = tid & 63, wave = __builtin_amdgcn_readfirstlane(tid >> 6);
    for (int it = bid * 8 + wave; it < 4608; it += G * 8) {
        int r = it; bool lat = true, ret = true;
        if (r >= 1024) { r -= 1024; ret = false; if (r >= 512) { r -= 512; lat = false; ret = true; if (r >= 2048) { r -= 2048; ret = false; } } }
        if (ret) { const int tile = r & 15, mat = r >> 4, dir = mat & 1, h = (mat >> 1) & 3, sl = mat >> 3; const float Gd = expf(128.f * logsigmoid_f(a.in[I_DECAY][dir * 4 + h]));
            if (lat) scan_ret<8>(RS, 32 + 8 * sl, h, dir, tile, a.in[I_SRET] + (size_t)((sl * 2 + dir) * 4 + h) * 32768, nullptr, Gd, lane);
            else scan_ret<2>(RS, 2 * sl, h, dir, tile, nullptr, a.out + OUT_SRET + (size_t)((sl * 2 + dir) * 4 + h) * 32768, Gd, lane);
        } else { const int vb = r & 7, mat = r >> 3, dir = mat & 1, h = (mat >> 1) & 3, sl = mat >> 3; const int o = (sl * 2 + dir) * 4 + h;
            if (lat) scan_ml<8>(MC, MN, MS, 32 + 8 * sl, h, dir, vb, a.in[I_SC] + (size_t)o * 16384, a.in[I_SN] + o * 128, a.in[I_SM][o], nullptr, nullptr, nullptr, lane);
            else scan_ml<2>(MC, MN, MS, 2 * sl, h, dir, vb, nullptr, nullptr, 0.f, a.out + OUT_SC + (size_t)o * 16384, a.out + OUT_SN + o * 128, a.out + OUT_SM + o, lane);
        }
    }
}

constexpr int NPHASE = 16;
#ifndef MK_PER_PHASE
#define MK_PER_PHASE 0
#endif
#ifndef MIX6
#define MIX6 1
#endif
#ifndef MIX7
#define MIX7 1
#endif
#ifndef MIX8
#define MIX8 1
#endif
#define MIXER_MFMA (MIX6 && MIX7 && MIX8)
#define GEMM_PHASE(EPI, g, S, E) pg8::gemm_phase<EPI, pg8::StaticOrder, true, true>((PG8_LAS unsigned char*)lds, g, S, E)

template <int K> __device__ __forceinline__ void run_phase(const Args& a, const Frame& F, LAS unsigned char* lds) {
    unsigned char* ws = a.ws; const float* mod = (const float*)(ws + WS_MOD);
    bf16* U = (bf16*)(ws + WS_U); bf16* H = (bf16*)(ws + WS_H); bf16* PA = (bf16*)(ws + WS_PA); bf16* BG = (bf16*)(ws + WS_BG); bf16* T1 = (bf16*)(ws + WS_T1);
    float* X = a.out + OUT_Y;
    if constexpr (K == 0) { p0_prologue(a, F); }
    if constexpr (K == 1) { norm_phase<false>(a, F, a.in[I_XP], a.in[I_XS], a.in[I_NF1], 0 * D, 1 * D); }
    if constexpr (K == 2) { pg8::Gemm g{U, (const bf16*)(ws + WS_W13A), MROWS, 2 * FF, D, D}; pg8::StaticOrder S; S.init(MROWS, 2 * FF, F.G, F.bid); EpiSwiGLU E{H}; GEMM_PHASE(EpiSwiGLU, g, S, E); }
    if constexpr (K == 3) { pg8::Gemm g{H, (const bf16*)(ws + WS_W2A), MROWS, D, FF, FF}; pg8::StaticOrder S; S.init(MROWS, D, F.G, F.bid); EpiResid E{a.in[I_XP], a.in[I_XS], X, mod + 2 * D, 0.5f}; GEMM_PHASE(EpiResid, g, S, E); }
    if constexpr (K == 4) { norm_phase<true>(a, F, X, X + (size_t)NCTX * D, a.in[I_NMIX], 3 * D, 4 * D); }
    if constexpr (K == 5) { pg8::Gemm g{U, (const bf16*)(ws + WS_WIN), MROWS, 4096, D, D}; pg8::StaticOrder S; S.init(MROWS, 4096, F.G, F.bid); EpiProjA E{PA, (const float2*)(ws + WS_ROPE)}; GEMM_PHASE(EpiProjA, g, S, E); }
    if constexpr (K == 6) { p6_mfma(a, F.tid, F.bid, F.G, lds); }
    if constexpr (K == 7) { p7_scan(a, F.tid, F.bid, F.G); }
    if constexpr (K == 8) { p8_mfma<3>(a, F.tid, F.bid, F.G, lds); }
    if constexpr (K == 81) { p8_mfma<1>(a, F.tid, F.bid, F.G, lds); }
    if constexpr (K == 83) { p8_mfma<1 + 4>(a, F.tid, F.bid, F.G, lds); }
    if constexpr (K == 84) { p8_mfma<1 + 8>(a, F.tid, F.bid, F.G, lds); }
    if constexpr (K == 85) { p8_mfma<1 + 16>(a, F.tid, F.bid, F.G, lds); }
    if constexpr (K == 86) { p8_mfma<2 + 32>(a, F.tid, F.bid, F.G, lds); }
    if constexpr (K == 87) { p8_mfma<2 + 64>(a, F.tid, F.bid, F.G, lds); }
    if constexpr (K == 82) { p8_mfma<2>(a, F.tid, F.bid, F.G, lds); }
    if constexpr (K == 9) { pg8::Gemm g{U, (const bf16*)(ws + WS_WIN) + (size_t)4096 * D, MROWS, 3072, D, D}; pg8::StaticOrder S; S.init(MROWS, 3072, F.G, F.bid); EpiProjB E{PA, BG}; GEMM_PHASE(EpiProjB, g, S, E); }
    if constexpr (K == 10) {
        { pg8::Gemm g{PA + C_RV, (const bf16*)(ws + WS_WR), MROWS, D, D, PA_LD}; pg8::StaticOrder S; S.init(MROWS, D, F.G, F.bid); EpiMerge<false> E{BG, T1, U}; GEMM_PHASE(EpiMerge<false>, g, S, E); }
        { pg8::Gemm g{PA + C_MV, (const bf16*)(ws + WS_WM), MROWS, D, 512, PA_LD}; pg8::StaticOrder S; S.init(MROWS, D, F.G, F.bid); EpiMerge<true> E{BG, T1, U}; GEMM_PHASE(EpiMerge<true>, g, S, E); }
    }
    if constexpr (K == 11) { pg8::Gemm g{U, (const bf16*)(ws + WS_WO), MROWS, D, D, D}; pg8::StaticOrder S; S.init(MROWS, D, F.G, F.bid); EpiResid E{X, X + (size_t)NCTX * D, X, mod + 5 * D, 1.0f}; GEMM_PHASE(EpiResid, g, S, E); }
    if constexpr (K == 12) { norm_phase<false>(a, F, X, X + (size_t)NCTX * D, a.in[I_NF2], 6 * D, 7 * D); }
    if constexpr (K == 13) { pg8::Gemm g{U, (const bf16*)(ws + WS_W13B), MROWS, 2 * FF, D, D}; pg8::StaticOrder S; S.init(MROWS, 2 * FF, F.G, F.bid); EpiSwiGLU E{H}; GEMM_PHASE(EpiSwiGLU, g, S, E); }
    if constexpr (K == 14) { pg8::Gemm g{H, (const bf16*)(ws + WS_W2B), MROWS, D, FF, FF}; pg8::StaticOrder S; S.init(MROWS, D, F.G, F.bid); EpiResid E{X, X + (size_t)NCTX * D, X, mod + 8 * D, 0.5f}; GEMM_PHASE(EpiResid, g, S, E); }
    if constexpr (K == 15) { final_norm_phase(a, F); }
}
#ifndef PROGRAM
#define PROGRAM P(0) P(1) P(2) P(3) P(4) P(5) P(6) P(7) P(8) P(9) P(10) P(11) P(12) P(13) P(14) L(15)
#endif
__global__ void __launch_bounds__(512, 2) fwd_kernel(Args a) {
    extern __shared__ __attribute__((aligned(16))) unsigned char lds[];
    Frame F; F.lds = lds; F.tid = threadIdx.x; F.lane = F.tid & 63; F.wave = __builtin_amdgcn_readfirstlane(F.tid >> 6);
    F.G = gridDim.x; F.bid = blockIdx.x; F.gw = F.bid * 8 + F.wave; F.ngw = F.G * 8;
    volatile LAS unsigned* MISC = (volatile LAS unsigned*)((LAS unsigned char*)lds + MISC_OFF);
    if (F.tid < 64) MISC[F.tid] = 0u;
    __syncthreads();
    XcdBarrier bar = xcd_barrier_post((unsigned*)(a.ws + WS_CTL) + CW_BAR, MISC + 8);
#define P(k) run_phase<k>(a, F, (LAS unsigned char*)lds); xcd_barrier(bar);
#define L(k) run_phase<k>(a, F, (LAS unsigned char*)lds);
    PROGRAM
#undef P
#undef L
}

extern "C" void kernel_launch(void* const* d_in, const int* in_sizes, int n_in, void* d_out, int out_size, void* d_ws, size_t ws_size, hipStream_t stream) {
    static int grid = 0;
    if (grid == 0) {
        if (n_in != 31 || (size_t)out_size != OUT_END || ws_size < WS_END) { fprintf(stderr, "kernel_launch: unexpected shapes: n_in %d out %d ws %zu\n", n_in, out_size, ws_size); grid = -1; return; }
        int dev = 0, cus = 0, per_cu = 0;
        if (hipGetDevice(&dev) != hipSuccess || hipDeviceGetAttribute(&cus, hipDeviceAttributeMultiprocessorCount, dev) != hipSuccess) { grid = -1; return; }
        if (hipFuncSetAttribute((const void*)fwd_kernel, hipFuncAttributeMaxDynamicSharedMemorySize, LDS_BYTES) != hipSuccess) { fprintf(stderr, "kernel_launch: hipFuncSetAttribute failed\n"); grid = -1; return; }
        if (hipOccupancyMaxActiveBlocksPerMultiprocessor(&per_cu, (const void*)fwd_kernel, 512, LDS_BYTES) != hipSuccess || per_cu < 1) { fprintf(stderr, "kernel_launch: occupancy query says %d blocks per CU\n", per_cu); grid = -1; return; }
        (void)hipGetLastError();
        grid = cus * 1;
    }
    if (grid < 0) return;
    (void)hipMemsetAsync((char*)d_ws + WS_CTL, 0, CTL_ZERO_BYTES, stream);
    Args a{};
    for (int i = 0; i < 31; ++i) a.in[i] = (const float*)d_in[i];
    a.out = (float*)d_out; a.ws = (unsigned char*)d_ws;
    a.ph_lo = 0; a.ph_hi = NPHASE;
    void* args[] = {&a};
    hipError_t e = hipLaunchCooperativeKernel((const void*)fwd_kernel, dim3(grid), dim3(512), args, LDS_BYTES, stream);
    if (e != hipSuccess) fprintf(stderr, "kernel_launch: cooperative launch failed: %s (grid %d)\n", hipGetErrorString(e), grid);
}
```

```cpp
#include <hip/hip_runtime.h>
#include <cstdio>
#include <cstdint>
namespace pg8 {
#define PG8_LAS __attribute__((address_space(3)))
typedef unsigned short bf16_t;
typedef short bf16x8 __attribute__((ext_vector_type(8)));
typedef float f32x4 __attribute__((ext_vector_type(4)));
typedef unsigned u32x4 __attribute__((ext_vector_type(4)));
constexpr int BM = 256, BK = 64, HALF = 128, HTB = HALF * BK * 2  , STAGE_BYTES = 8 * HTB, NXCD = 8, WGM = 8;

__host__ __device__ __forceinline__ int lds_byte(int r, int c) { const int st = (r >> 4) * 2 + (c >> 5), rr = r & 15, cc = c & 31, ob = rr * 64 + cc * 2; return st * 1024 + (ob ^ (((ob >> 9) & 1) << 5)); }
__host__ __device__ __forceinline__ void stage_rc(int b, int& R, int& C) { const int st = b / 1024, sb = b % 1024, swz = sb ^ (((sb >> 9) & 1) << 5); R = (st >> 1) * 16 + swz / 64; C = (st & 1) * 32 + (swz % 64) / 2; }
__host__ __device__ __forceinline__ int perm32(int rho) { const int n = rho >> 4, i = rho & 15; return 8 * (i >> 2) + 4 * n + (i & 3); }

struct Unit { int pm, pn; };
struct Gemm { const bf16_t* A; const bf16_t* Bt; int M, N, K, lda; };

struct StaticOrder {
    int nM, nN, nwg, G, c;
    __host__ __device__ void init(int M, int N, int G_, int c_, int bm = BM) { nM = M / bm; nN = N / BM; nwg = nM * nN; G = G_; c = c_; }
    __host__ __device__ bool next(int i, Unit& u) const {
        const long L = (long)i * G + c; if (L >= nwg) return false;
        int wgid = (int)L; { const int q = nwg / NXCD, r = nwg % NXCD, xcd = wgid % NXCD, off = wgid / NXCD; wgid = (xcd < r ? xcd * (q + 1) : r * (q + 1) + (xcd - r) * q) + off; }
        const int nig = WGM * nN, gid = wgid / nig, fm = gid * WGM, gsz = (nM - fm) < WGM ? (nM - fm) : WGM;
        u.pm = fm + ((wgid % nig) % gsz); u.pn = (wgid % nig) / gsz; return true;
    }
    __device__ __forceinline__ void a_ready(const Unit&) const {}
    __device__ __forceinline__ void done(const Unit&) const {}
};

__device__ __forceinline__ unsigned cvt_pk_bf16(float lo, float hi) { unsigned r; asm volatile("v_cvt_pk_bf16_f32 %0, %1, %2" : "=v"(r) : "v"(lo), "v"(hi)); return r; }
template <class Epi, class Sched, bool ALIGN_EPI = false, bool SP2 = false, int MT = 4>
__device__ __forceinline__ void gemm_phase(PG8_LAS unsigned char* lds, const Gemm g, const Sched& S, const Epi& E) {
    int tid_l = threadIdx.x; asm volatile("" : "+v"(tid_l)); const int tid = tid_l, wid = __builtin_amdgcn_readfirstlane(tid >> 6), lane = tid & 63, wr = wid >> 2, wc = wid & 3, fr = lane & 15, fq = lane >> 4;
    const int K = g.K, nt = K / BK;
    unsigned voffA[2], voffB[2];
#pragma unroll
    for (int i = 0; i < 2; ++i) { int R, C; stage_rc(tid * 16 + i * 8192, R, C); const int Rb = Epi::PERM ? ((R & ~31) + perm32(R & 31)) : R;
        const int Ra = (MT == 3 && R >= 96) ? R - 32 : R;
        voffA[i] = (unsigned)(Ra * g.lda + C) * 2u; voffB[i] = (unsigned)(Rb * K + C) * 2u; }
    const size_t kstep = (size_t)(BK * 2);
    const size_t hstep = (size_t)HALF * K * 2;
    const size_t tstep = 2 * hstep; const size_t hstepA = (size_t)(MT * 32) * g.lda * 2, tstepA = 2 * hstepA;
    const bool a_dummy = (MT == 3) && (wid >= 4);
    const unsigned ldsw = (unsigned)wid * 1024u;
    const int aoff = lds_byte(wr * (MT * 16) + fr, fq * 8), boff = lds_byte(wc * 32 + fr, fq * 8);
#define PG8_SA(b, h) (((b) * 2 + (h)) * HTB)
#define PG8_SB(b, h) ((4 + (b) * 2 + (h)) * HTB)
#define PG8_STAGE(bufoff, gbase, voff) do { _Pragma("unroll") for (int _i = 0; _i < 2; ++_i) \
        __builtin_amdgcn_global_load_lds((const unsigned*)((const char*)(gbase) + (voff)[_i]), (PG8_LAS unsigned*)(lds + (bufoff) + ldsw + _i * 8192), 16, 0, 0); } while (0)
#define PG8_STAGEA(bufoff, gbase, voff) do { \
        __builtin_amdgcn_global_load_lds((const unsigned*)((const char*)(gbase) + (voff)[0]), (PG8_LAS unsigned*)(lds + (bufoff) + ldsw), 16, 0, 0); \
        __builtin_amdgcn_global_load_lds((const unsigned*)((const char*)(gbase) + (voff)[1]), (PG8_LAS unsigned*)(lds + (a_dummy ? (unsigned)(STAGE_BYTES + ldsw - 4096u) : (unsigned)((bufoff) + ldsw + 8192))), 16, 0, 0); } while (0)
#define PG8_LDA(dst, b, h) do { _Pragma("unroll") for (int m = 0; m < MT; ++m) _Pragma("unroll") for (int k = 0; k < 2; ++k) dst[m][k] = *(const PG8_LAS bf16x8*)(lds + PG8_SA(b, h) + aoff + m * 2048 + k * 1024); } while (0)
#define PG8_LDB(dst, b, h) do { _Pragma("unroll") for (int n = 0; n < 2; ++n) _Pragma("unroll") for (int k = 0; k < 2; ++k) dst[n][k] = *(const PG8_LAS bf16x8*)(lds + PG8_SB(b, h) + boff + n * 2048 + k * 1024); } while (0)
#define PG8_MMA(ai, bj, At, Bt) do { __builtin_amdgcn_s_setprio(1); _Pragma("unroll") for (int m = 0; m < MT; ++m) _Pragma("unroll") for (int n = 0; n < 2; ++n) _Pragma("unroll") for (int k = 0; k < 2; ++k) \
        acc[ai][bj][m][n] = __builtin_amdgcn_mfma_f32_16x16x32_bf16(Bt[n][k], At[m][k], acc[ai][bj][m][n], 0, 0, 0); __builtin_amdgcn_s_setprio(0); } while (0)
#define PG8_WAIT_V(n) asm volatile("s_waitcnt vmcnt(" #n ")" ::: "memory")
#define PG8_WAIT_L(n) asm volatile("s_waitcnt lgkmcnt(" #n ")" ::: "memory")
#define PG8_BAR __builtin_amdgcn_s_barrier()
#define PG8_SCHED __builtin_amdgcn_sched_barrier(0)
    Unit cur, nxt; int ui = 0;
    if (!S.next(0, cur)) return;
    f32x4 acc[2][2][MT][2];
#pragma unroll
    for (int a = 0; a < 2; ++a)
#pragma unroll
        for (int b = 0; b < 2; ++b)
#pragma unroll
            for (int m = 0; m < MT; ++m)
#pragma unroll
                for (int n = 0; n < 2; ++n) acc[a][b][m][n] = (f32x4){0.f, 0.f, 0.f, 0.f};
    bf16x8 At[MT][2], B0[2][2], B1[2][2];
    const char* cA = (const char*)g.A + (size_t)cur.pm * tstepA; const char* cB = (const char*)g.Bt + (size_t)cur.pn * tstep;
    S.a_ready(cur);
    if constexpr (SP2) {
        PG8_STAGE(PG8_SB(0, 0), cB, voffB); PG8_STAGE(PG8_SB(0, 1), cB + hstep, voffB); PG8_STAGEA(PG8_SA(0, 0), cA, voffA); PG8_STAGEA(PG8_SA(0, 1), cA + hstepA, voffA);
        if (wr == 1) PG8_BAR;
        PG8_WAIT_V(2); PG8_BAR;
        PG8_STAGE(PG8_SB(1, 0), cB + kstep, voffB); PG8_STAGEA(PG8_SA(1, 0), cA + kstep, voffA); PG8_STAGE(PG8_SB(1, 1), cB + hstep + kstep, voffB);
        PG8_WAIT_V(6); PG8_BAR;
    } else {
        PG8_STAGE(PG8_SB(0, 0), cB, voffB); PG8_STAGEA(PG8_SA(0, 0), cA, voffA); PG8_STAGE(PG8_SB(0, 1), cB + hstep, voffB); PG8_STAGEA(PG8_SA(0, 1), cA + hstepA, voffA);
        if (wr == 1) PG8_BAR;
        PG8_WAIT_V(4); PG8_BAR;
        PG8_STAGE(PG8_SB(1, 0), cB + kstep, voffB); PG8_STAGEA(PG8_SA(1, 0), cA + kstep, voffA); PG8_STAGE(PG8_SB(1, 1), cB + hstep + kstep, voffB);
        PG8_WAIT_V(6); PG8_BAR;
    }
    for (;;) {
        const bool has_next = S.next(ui + 1, nxt);
        const char* nA = has_next ? (const char*)g.A + (size_t)nxt.pm * tstepA : cA; const char* nB = has_next ? (const char*)g.Bt + (size_t)nxt.pn * tstep : cB;
        for (int t = 0; t < nt; t += 2) {
            const bool last = (t == nt - 2);
            const char* a1 = cA + (size_t)(t + 1) * kstep;
            const char* a2 = last ? nA : cA + (size_t)(t + 2) * kstep; const char* b2 = last ? nB : cB + (size_t)(t + 2) * kstep;
            const char* a3 = a2 + kstep; const char* b3 = b2 + kstep;
            if (last && has_next) S.a_ready(nxt);
            if constexpr (SP2) {
            PG8_LDB(B0, 0, 0); PG8_LDB(B1, 0, 1); PG8_SCHED; PG8_LDA(At, 0, 0); PG8_STAGEA(PG8_SA(1, 1), a1 + hstepA, voffA);
            PG8_WAIT_V(8); PG8_WAIT_L(0); PG8_BAR; PG8_MMA(0, 0, At, B0); PG8_MMA(0, 1, At, B1); PG8_BAR; PG8_SCHED;
            PG8_LDA(At, 0, 1); PG8_STAGE(PG8_SB(0, 0), b2, voffB); PG8_STAGE(PG8_SB(0, 1), b2 + hstep, voffB); PG8_STAGEA(PG8_SA(0, 0), a2, voffA);
            PG8_WAIT_V(8); PG8_WAIT_L(0); PG8_BAR; PG8_MMA(1, 0, At, B0); PG8_MMA(1, 1, At, B1); PG8_BAR; PG8_SCHED;
            PG8_LDB(B0, 1, 0); PG8_LDB(B1, 1, 1); PG8_SCHED; PG8_LDA(At, 1, 0); PG8_STAGEA(PG8_SA(0, 1), a2 + hstepA, voffA);
            PG8_WAIT_V(8); PG8_WAIT_L(0); PG8_BAR; PG8_MMA(0, 0, At, B0); PG8_MMA(0, 1, At, B1); PG8_BAR; PG8_SCHED;
            PG8_LDA(At, 1, 1); PG8_STAGE(PG8_SB(1, 0), b3, voffB); PG8_STAGE(PG8_SB(1, 1), b3 + hstep, voffB); PG8_STAGEA(PG8_SA(1, 0), a3, voffA);
            PG8_WAIT_V(8); PG8_WAIT_L(0); PG8_BAR; PG8_MMA(1, 0, At, B0); PG8_MMA(1, 1, At, B1); PG8_BAR; PG8_SCHED;
            } else {
            PG8_LDB(B0, 0, 0); PG8_SCHED; PG8_LDA(At, 0, 0); PG8_STAGEA(PG8_SA(1, 1), a1 + hstepA, voffA);
            PG8_WAIT_L(8); PG8_BAR; PG8_WAIT_L(0); PG8_MMA(0, 0, At, B0); PG8_BAR; PG8_SCHED;
            PG8_LDB(B1, 0, 1); PG8_STAGE(PG8_SB(0, 0), b2, voffB);
            PG8_BAR; PG8_WAIT_L(0); PG8_MMA(0, 1, At, B1); PG8_BAR;
            PG8_LDA(At, 0, 1); PG8_STAGEA(PG8_SA(0, 0), a2, voffA);
            PG8_BAR; PG8_WAIT_L(0); PG8_MMA(1, 0, At, B0); PG8_BAR; PG8_SCHED;
            PG8_STAGE(PG8_SB(0, 1), b2 + hstep, voffB);
            PG8_WAIT_V(6); PG8_BAR; PG8_MMA(1, 1, At, B1); PG8_BAR;
            PG8_LDB(B0, 1, 0); PG8_SCHED; PG8_LDA(At, 1, 0); PG8_STAGEA(PG8_SA(0, 1), a2 + hstepA, voffA);
            PG8_WAIT_L(8); PG8_BAR; PG8_WAIT_L(0); PG8_MMA(0, 0, At, B0); PG8_BAR; PG8_SCHED;
            PG8_LDB(B1, 1, 1); PG8_STAGE(PG8_SB(1, 0), b3, voffB);
            PG8_BAR; PG8_WAIT_L(0); PG8_MMA(0, 1, At, B1); PG8_BAR;
            PG8_LDA(At, 1, 1); PG8_STAGEA(PG8_SA(1, 0), a3, voffA);
            PG8_BAR; PG8_WAIT_L(0); PG8_MMA(1, 0, At, B0); PG8_BAR; PG8_SCHED;
            PG8_STAGE(PG8_SB(1, 1), b3 + hstep, voffB);
            PG8_WAIT_V(6); PG8_BAR; PG8_MMA(1, 1, At, B1); PG8_BAR;
            }
        }
        if constexpr (ALIGN_EPI) { if (wr == 0) PG8_BAR; }
        if constexpr (!Epi::AFTER_DRAIN) { E(acc, cur, wr, wc, fr, fq); S.done(cur); }
        if (!has_next) break;
#pragma unroll
        for (int a = 0; a < 2; ++a)
#pragma unroll
            for (int b = 0; b < 2; ++b)
#pragma unroll
                for (int m = 0; m < MT; ++m)
#pragma unroll
                    for (int n = 0; n < 2; ++n) acc[a][b][m][n] = (f32x4){0.f, 0.f, 0.f, 0.f};
        cur = nxt; cA = nA; cB = nB; ++ui;
        if constexpr (ALIGN_EPI) { if (wr == 1) PG8_BAR; }
    }
    PG8_WAIT_V(0);
    if constexpr (!ALIGN_EPI) { if (wr == 0) PG8_BAR; }
    PG8_BAR;
    if constexpr (Epi::AFTER_DRAIN) { E.fused(acc, cur, wr, wc, fr, fq, lds, wid, lane); S.done(cur); }
#undef PG8_SA
#undef PG8_SB
#undef PG8_STAGE
#undef PG8_STAGEA
#undef PG8_LDA
#undef PG8_LDB
#undef PG8_MMA
#undef PG8_WAIT_V
#undef PG8_WAIT_L
#undef PG8_BAR
#undef PG8_SCHED
}
}

constexpr int D = 1024, NCTX = 4096, MROWS = 12288, FF = 2816;
constexpr int CH = 128, NCHUNK = 96, NHEAD = 4;
constexpr int PA_LD = 4096;
constexpr int C_RQ = 0, C_RK = 512, C_RV = 1024, C_MQ = 2048, C_MK = 2560, C_MV = 3072, C_MO = 3584;
constexpr int MODW = 9216;
constexpr float EPS_RMS = 1e-6f, EPS_GN = 1e-5f;
constexpr size_t OUT_Y = 0, OUT_SRET = (size_t)MROWS * D, OUT_SC = OUT_SRET + 16ull * 2 * 4 * 128 * 256, OUT_SN = OUT_SC + 16ull * 2 * 4 * 128 * 128, OUT_SM = OUT_SN + 16ull * 2 * 4 * 128, OUT_END = OUT_SM + 128;
constexpr size_t MiB = 1u << 20, KiB = 1024;
constexpr size_t WS_CTL = 0, CTL_ZERO_BYTES = 64 * KiB;
constexpr size_t WS_MOD = 1 * MiB;
constexpr size_t WS_WG = 1 * MiB + 384 * KiB;
constexpr size_t WS_ROPE = 2 * MiB;
constexpr size_t WS_IG = 2 * MiB + 512 * KiB;
constexpr size_t WS_LF = WS_IG + 384 * KiB;
constexpr size_t WS_MN = WS_LF + 384 * KiB;
constexpr size_t WS_MS = WS_MN + 384 * KiB;
constexpr size_t WS_W13A = 4 * MiB, WS_W2A = 15 * MiB, WS_W13B = 20 * MiB + 512 * KiB, WS_W2B = 31 * MiB + 512 * KiB;
constexpr size_t WS_WIN = 37 * MiB, WS_WR = 51 * MiB, WS_WM = 53 * MiB, WS_WO = 54 * MiB;
constexpr size_t WS_U = 56 * MiB;
constexpr size_t WS_BIG = 80 * MiB;
constexpr size_t WS_H = WS_BIG;
constexpr size_t WS_PA = WS_BIG;
constexpr size_t WS_RS = 176 * MiB;
constexpr size_t WS_MC = 224 * MiB;
constexpr size_t WS_BG = WS_RS;
constexpr size_t WS_T1 = WS_MC;
constexpr size_t WS_END = 248 * MiB;
static_assert(WS_MS + 16 * KiB <= WS_W13A, "ws map");
constexpr int CW_BAR = 1024;

constexpr int LDS_BYTES = 147456;
constexpr int RING_BYTES = 131072;
constexpr int MISC_OFF = LDS_BYTES - 256;

#define GAS __attribute__((address_space(1)))
#define LAS __attribute__((address_space(3)))
typedef unsigned short bf16;
typedef unsigned v4u __attribute__((ext_vector_type(4)));
typedef unsigned v2u __attribute__((ext_vector_type(2)));
typedef float f32x4 __attribute__((ext_vector_type(4)));
typedef GAS unsigned gu32;
#define RLX_AGENT __ATOMIC_RELAXED, __HIP_MEMORY_SCOPE_AGENT
#define LDS_WAIT() asm volatile("s_waitcnt lgkmcnt(0)" ::: "memory")
#define VM_WAIT() asm volatile("s_waitcnt vmcnt(0)" ::: "memory")
__device__ __forceinline__ unsigned f2bf(float f) { unsigned u = __builtin_bit_cast(unsigned, f); return (u + 0x7fffu + ((u >> 16) & 1u)) >> 16; }
__device__ __forceinline__ unsigned pk2(float lo, float hi) { return f2bf(lo) | (f2bf(hi) << 16); }
__device__ __forceinline__ float bf2f(unsigned short b) { return __builtin_bit_cast(float, (unsigned)b << 16); }
__device__ __forceinline__ float bflo(unsigned w) { return __builtin_bit_cast(float, w << 16); }
__device__ __forceinline__ float bfhi(unsigned w) { return __builtin_bit_cast(float, w & 0xffff0000u); }
__device__ __forceinline__ float silu_f(float x) { return x / (1.f + __expf(-x)); }
__device__ __forceinline__ float sigmoid_f(float x) { return 1.f / (1.f + __expf(-x)); }
__device__ __forceinline__ float logsigmoid_f(float x) { return fminf(x, 0.f) - log1pf(expf(-fabsf(x))); }
__device__ __forceinline__ float wave_sum(float v) {
#pragma unroll
    for (int o = 1; o < 64; o <<= 1) v += __shfl_xor(v, o);
    return v;
}
#define XB_TMO      128
#define XB_XCNT(j)  (256  + 64 * (j))
#define XB_XSUB(j)  (1280 + 64 * (j))
#define XB_XGEN(j)  (2304 + 64 * (j))
#define XB_TOP      3328
#define XB_TOPGEN   3392
#define XCD_BAR_WORDS 3456
#define XB_SPIN_CAP (1u << 18)

__device__ __forceinline__ unsigned xb_ld(unsigned* p)              { return __hip_atomic_load(p, __ATOMIC_RELAXED, __HIP_MEMORY_SCOPE_AGENT); }
__device__ __forceinline__ unsigned xb_add(unsigned* p, unsigned v) { return __hip_atomic_fetch_add(p, v, __ATOMIC_RELAXED, __HIP_MEMORY_SCOPE_AGENT); }
__device__ __forceinline__ unsigned xb_xcc_id() { return (unsigned)__builtin_amdgcn_s_getreg((3 << 11) | 20) & 0xFu; }
#define XB_SPIN(cond, bar) do { unsigned _sp = 0; while (cond) { __builtin_amdgcn_s_sleep(1); \
    if ((++_sp & 255u) == 0u) { if (xb_ld(&(bar)[XB_TMO])) break; if (_sp > XB_SPIN_CAP) { atomicAdd(&(bar)[XB_TMO], 1u); break; } } } } while (0)

struct XcdBarrier {
    unsigned* bar; unsigned x;
    volatile LAS unsigned* st;
};

__device__ __forceinline__ XcdBarrier xcd_barrier_post(unsigned* bar, volatile LAS unsigned* st) {
    XcdBarrier b; b.bar = bar; b.x = xb_xcc_id(); b.st = st;
    if (threadIdx.x == 0) (void)xb_add(&bar[XB_XCNT(b.x)], 1u);
    return b;
}
__device__ __forceinline__ void xcd_barrier_complete(unsigned* bar, unsigned x, unsigned& nloc, unsigned& nx) {
    const unsigned G = gridDim.x * gridDim.y * gridDim.z;
    unsigned sum, cnt, mine, sp = 0u;
    for (;;) {
        sum = 0u; cnt = 0u; mine = 0u;
#pragma unroll
        for (unsigned j = 0; j < 16; ++j) { const unsigned c = xb_ld(&bar[XB_XCNT(j)]); sum += c; cnt += (c > 0u) ? 1u : 0u; mine = (j == x) ? c : mine; }
        if (sum == G) break;
        __builtin_amdgcn_s_sleep(1);
        if ((++sp & 255u) == 0u) { if (xb_ld(&bar[XB_TMO])) break; if (sp > XB_SPIN_CAP) { atomicAdd(&bar[XB_TMO], 1u); break; } }
    }
    nloc = mine > 0u ? mine : 1u; nx = cnt > 0u ? cnt : 1u;
}

__device__ __forceinline__ void xcd_barrier(const XcdBarrier& b) {
    asm volatile("s_waitcnt vmcnt(0)" ::: "memory");
    __syncthreads();
    if (threadIdx.x == 0) {
        unsigned* bar = b.bar;
        __builtin_amdgcn_s_waitcnt(0);
        unsigned nloc = b.st[0], nx = b.st[1];
        if (nloc == 0u) { xcd_barrier_complete(bar, b.x, nloc, nx); b.st[0] = nloc; b.st[1] = nx; }
        const unsigned old = xb_add(&bar[XB_XSUB(b.x)], 1u);
        const unsigned gen = old / nloc;
        if (old + 1u == (gen + 1u) * nloc) {
            __builtin_amdgcn_fence(__ATOMIC_RELEASE, "agent");
            asm volatile("s_waitcnt vmcnt(0)" ::: "memory");
            const unsigned og = xb_add(&bar[XB_TOP], 1u);
            const unsigned tg = og / nx;
            if (og + 1u == (tg + 1u) * nx) xb_add(&bar[XB_TOPGEN], 1u);
            else XB_SPIN(xb_ld(&bar[XB_TOPGEN]) == tg, bar);
            __builtin_amdgcn_fence(__ATOMIC_ACQUIRE, "agent");
            xb_add(&bar[XB_XGEN(b.x)], 1u);
            asm volatile("s_waitcnt vmcnt(0)" ::: "memory");
        } else {
            XB_SPIN(xb_ld(&bar[XB_XGEN(b.x)]) == gen, bar);
            __builtin_amdgcn_fence(__ATOMIC_ACQUIRE, "agent");
            asm volatile("s_waitcnt vmcnt(0)" ::: "memory");
        }
    }
    __syncthreads();
}

struct Args { const float* in[31]; float* out; unsigned char* ws; int ph_lo, ph_hi; };
enum { I_XP = 0, I_XS, I_C, I_SRET, I_SC, I_SN, I_SM, I_CCTX, I_WADA, I_BADA, I_NF1, I_W1A, I_W3A, I_W2A, I_NMIX, I_WIN, I_CONVW, I_CONVB,
       I_DECAY, I_BIG, I_BFG, I_RETGN, I_MGN, I_WRUP, I_WMUP, I_WOUT, I_NF2, I_W1B, I_W3B, I_W2B, I_NFIN };

struct Frame {
    unsigned char* lds;
    int tid, lane, wave, G, bid, gw, ngw;
};

__device__ __forceinline__ int mod_row(int row) { return row < NCTX ? 0 : 1 + ((row - NCTX) >> 10); }

__device__ __forceinline__ int rope_perm(int p) { const int s = p >> 6, i = p & 63; return 8 * (i >> 2) + 4 * s + (i & 3); }
template <int MODE>
__device__ __forceinline__ void p0_tr_item(const float* W, int ldw, int col0, int K, int ncols, bf16* WT, int row_off, float* scr, int item, int lane) {
    const int nblk = ncols / 32, kb = item / nblk, nb = item % nblk, k0 = 64 * kb, n0 = 32 * nb;
    float tv[32];
#pragma unroll
    for (int i = 0; i < 32; ++i) tv[i] = W[(size_t)(k0 + 2 * i + (lane >> 5)) * ldw + col0 + n0 + (lane & 31)];
#pragma unroll
    for (int i = 0; i < 32; ++i) scr[(2 * i + (lane >> 5)) * 33 + (lane & 31)] = tv[i];
    LDS_WAIT(); asm volatile("" ::: "memory");
    const int c = lane & 7;
#pragma unroll
    for (int j = 0; j < 4; ++j) { const int n = (lane >> 3) + 8 * j, nn = n0 + n; const float* s = scr + (8 * c) * 33 + n;
        int drow;
        if (MODE == 0) drow = row_off + nn; else if (MODE == 1) drow = row_off + (nn & ~127) + rope_perm(nn & 127); else drow = row_off + 256 * (nn >> 7) + (nn & 127);
        v4u o; o.x = pk2(s[0 * 33], s[1 * 33]); o.y = pk2(s[2 * 33], s[3 * 33]); o.z = pk2(s[4 * 33], s[5 * 33]); o.w = pk2(s[6 * 33], s[7 * 33]);
        *(v4u*)(WT + (size_t)drow * K + k0 + 8 * c) = o; }
    LDS_WAIT(); asm volatile("" ::: "memory");
}

__device__ __forceinline__ void p0_prologue(const Args& a, const Frame& F) {
    unsigned char* ws = a.ws;
    float* mod = (float*)(ws + WS_MOD);
    if (F.bid < MODW / 64) {
        float* sc = (float*)F.lds;
        float* part = (float*)(F.lds + 40960);
        for (int idx = F.tid; idx < 9 * 1024; idx += 512) { const int r = idx >> 10, k = idx & 1023; const float v = r == 0 ? a.in[I_CCTX][k] : a.in[I_C][(r - 1) * 1024 + k]; sc[idx] = v / (1.f + expf(-v)); }
        __syncthreads();
        const int c0 = 64 * F.bid, k0 = 128 * F.wave; const float* wp = a.in[I_WADA] + (size_t)k0 * MODW + c0 + F.lane;
        float acc[9];
#pragma unroll
        for (int r = 0; r < 9; ++r) acc[r] = 0.f;
#pragma unroll 32
        for (int kk = 0; kk < 128; ++kk) { const float wv = wp[(size_t)kk * MODW];
#pragma unroll
            for (int r = 0; r < 9; ++r) acc[r] += sc[r * 1024 + k0 + kk] * wv; }
#pragma unroll
        for (int r = 0; r < 9; ++r) part[(F.wave * 9 + r) * 64 + F.lane] = acc[r];
        __syncthreads();
        for (int idx = F.tid; idx < 9 * 64; idx += 512) { const int r = idx >> 6, l = idx & 63; float s = 0.f;
#pragma unroll
            for (int w = 0; w < 8; ++w) s += part[(w * 9 + r) * 64 + l];
            mod[r * MODW + c0 + l] = s + a.in[I_BADA][c0 + l]; }
        __syncthreads();
    }
    { float* wg = (float*)(ws + WS_WG); const int gt = F.bid * 512 + F.tid, ngt = F.G * 512;
      for (int idx = gt; idx < 16 * 1024; idx += ngt) { const int c = idx >> 10, k = idx & 1023; wg[idx] = a.in[I_WIN][(size_t)k * 7184 + 5120 + c]; }
      float2* rope = (float2*)(ws + WS_ROPE);
      for (int idx = gt; idx < 1024 * 64; idx += ngt) { const int t = idx >> 6, i = idx & 63, f = i & 31; const float freq = exp2f(-(float)f * (13.287712379549449f / 32.f));
          const float pos = (float)(i < 32 ? (t >> 6) : (t & 63)); const float ang = pos * freq; rope[idx] = make_float2(cosf(ang), sinf(ang)); } }
}
constexpr int CV_FFN1 = 4224, CV_WIN = 7808, CV_SMALL = 9088, CV_UP2 = 11904, CV_END = 13312;
__device__ __forceinline__ void p0_convert(const Args& a, const Frame& F, int lo, int hi, int wv, int nwv) {
    unsigned char* ws = a.ws;
    float* scr = (float*)(F.lds + F.wave * 16384);
    bf16* W13A = (bf16*)(ws + WS_W13A); bf16* W2A = (bf16*)(ws + WS_W2A); bf16* W13B = (bf16*)(ws + WS_W13B); bf16* W2B = (bf16*)(ws + WS_W2B);
    bf16* WIN = (bf16*)(ws + WS_WIN); bf16* WR = (bf16*)(ws + WS_WR); bf16* WM = (bf16*)(ws + WS_WM); bf16* WO = (bf16*)(ws + WS_WO);
    constexpr int I_UP = 16 * 88, I_DN = 44 * 32, I_512 = 16 * 32, I_1024 = 16 * 64, I_MUP = 8 * 32;
    static_assert(3 * I_UP == CV_FFN1 && CV_FFN1 + 3 * I_512 + 2 * I_1024 == CV_WIN && CV_WIN + 2 * I_512 + I_MUP == CV_SMALL && CV_SMALL + 2 * I_UP == CV_UP2 && CV_UP2 + I_DN == CV_END, "item map");
    for (int it = lo + wv; it < hi; it += nwv) {
        int r = it;
        if (r < I_UP) { p0_tr_item<2>(a.in[I_W1A], FF, 0, D, FF, W13A, 0, scr, r, F.lane); continue; } r -= I_UP;
        if (r < I_UP) { p0_tr_item<2>(a.in[I_W3A], FF, 0, D, FF, W13A, 128, scr, r, F.lane); continue; } r -= I_UP;
        if (r < I_DN) { p0_tr_item<0>(a.in[I_W2A], D, 0, FF, D, W2A, 0, scr, r, F.lane); continue; } r -= I_DN;
        if (r < I_512) { p0_tr_item<1>(a.in[I_WIN], 7184, 0, D, 1024, WIN, 0, scr, r, F.lane); continue; } r -= I_512;
        if (r < I_512) { p0_tr_item<0>(a.in[I_WIN], 7184, 1024, D, 1024, WIN, 1024, scr, r, F.lane); continue; } r -= I_512;
        if (r < I_1024) { p0_tr_item<0>(a.in[I_WIN], 7184, 3072, D, 2048, WIN, 2048, scr, r, F.lane); continue; } r -= I_1024;
        if (r < I_512) { p0_tr_item<0>(a.in[I_WIN], 7184, 2048, D, 1024, WIN, 4096, scr, r, F.lane); continue; } r -= I_512;
        if (r < I_1024) { p0_tr_item<0>(a.in[I_WIN], 7184, 5136, D, 2048, WIN, 5120, scr, r, F.lane); continue; } r -= I_1024;
        if (r < I_512) { p0_tr_item<0>(a.in[I_WRUP], D, 0, D, D, WR, 0, scr, r, F.lane); continue; } r -= I_512;
        if (r < I_MUP) { p0_tr_item<0>(a.in[I_WMUP], D, 0, 512, D, WM, 0, scr, r, F.lane); continue; } r -= I_MUP;
        if (r < I_512) { p0_tr_item<0>(a.in[I_WOUT], D, 0, D, D, WO, 0, scr, r, F.lane); continue; } r -= I_512;
        if (r < I_UP) { p0_tr_item<2>(a.in[I_W1B], FF, 0, D, FF, W13B, 0, scr, r, F.lane); continue; } r -= I_UP;
        if (r < I_UP) { p0_tr_item<2>(a.in[I_W3B], FF, 0, D, FF, W13B, 128, scr, r, F.lane); continue; } r -= I_UP;
        p0_tr_item<0>(a.in[I_W2B], D, 0, FF, D, W2B, 0, scr, r, F.lane);
    }
}

template <bool GATES>
__device__ __forceinline__ void norm_phase(const Args& a, const Frame& F, const float* x0, const float* x1, const float* nw, int sh_off, int sc_off) {
    const float* mod = (const float*)(a.ws + WS_MOD); bf16* U = (bf16*)(a.ws + WS_U);
    float* wgs = (float*)F.lds;
    if (GATES) { const float* wg = (const float*)(a.ws + WS_WG); for (int i = F.tid; i < 16 * 1024 / 4; i += 512) ((f32x4*)wgs)[i] = ((const f32x4*)wg)[i]; __syncthreads(); }
    f32x4 nwv[4];
#pragma unroll
    for (int j = 0; j < 4; ++j) nwv[j] = ((const f32x4*)nw)[F.lane + 64 * j];
    for (int row = F.gw; row < MROWS; row += F.ngw) {
        const float* xr = row < NCTX ? x0 + (size_t)row * D : x1 + (size_t)(row - NCTX) * D;
        const int mr = mod_row(row); const float* shp = mod + mr * MODW + sh_off; const float* scp = mod + mr * MODW + sc_off;
        f32x4 v[4]; float ss = 0.f;
#pragma unroll
        for (int j = 0; j < 4; ++j) { v[j] = ((const f32x4*)xr)[F.lane + 64 * j]; ss += (v[j].x * v[j].x + v[j].y * v[j].y) + (v[j].z * v[j].z + v[j].w * v[j].w); }
        const float rstd = 1.f / sqrtf(wave_sum(ss) * (1.f / D) + EPS_RMS);
        unsigned long long* o8 = (unsigned long long*)(U + (size_t)row * D) + F.lane;
#pragma unroll
        for (int j = 0; j < 4; ++j) { const f32x4 sh = ((const f32x4*)shp)[F.lane + 64 * j], sc = ((const f32x4*)scp)[F.lane + 64 * j];
            v[j] = v[j] * rstd * nwv[j] * (sc + 1.f) + sh;
            o8[64 * j] = (unsigned long long)pk2(v[j].x, v[j].y) | ((unsigned long long)pk2(v[j].z, v[j].w) << 32); }
        if (GATES) {
            float* IG = (float*)(a.ws + WS_IG); float* LF = (float*)(a.ws + WS_LF);
            float p[16];
#pragma unroll
            for (int c = 0; c < 16; ++c) { float acc = 0.f;
#pragma unroll
                for (int j = 0; j < 4; ++j) { const f32x4 w = ((const f32x4*)(wgs + c * 1024))[F.lane + 64 * j]; acc += (v[j].x * w.x + v[j].y * w.y) + (v[j].z * w.z + v[j].w * w.w); }
                p[c] = acc; if ((c & 1) == 1) __builtin_amdgcn_sched_barrier(0); }
            const bool b5 = F.lane & 32, b4 = F.lane & 16, b3 = F.lane & 8, b2 = F.lane & 4;
            float q[8], r4[4], s2[2];
#pragma unroll
            for (int c = 0; c < 8; ++c) { const float snd = b5 ? p[c] : p[c + 8], kp = b5 ? p[c + 8] : p[c]; q[c] = kp + __shfl_xor(snd, 32); }
#pragma unroll
            for (int c = 0; c < 4; ++c) { const float snd = b4 ? q[c] : q[c + 4], kp = b4 ? q[c + 4] : q[c]; r4[c] = kp + __shfl_xor(snd, 16); }
#pragma unroll
            for (int c = 0; c < 2; ++c) { const float snd = b3 ? r4[c] : r4[c + 2], kp = b3 ? r4[c + 2] : r4[c]; s2[c] = kp + __shfl_xor(snd, 8); }
            float t = (b2 ? s2[1] : s2[0]) + __shfl_xor(b2 ? s2[0] : s2[1], 4);
            t += __shfl_xor(t, 1); t += __shfl_xor(t, 2);
            const int col = ((F.lane >> 5) & 1) * 8 + ((F.lane >> 4) & 1) * 4 + ((F.lane >> 3) & 1) * 2 + ((F.lane >> 2) & 1);
            if ((F.lane & 3) == 0) { if (col < 8) IG[(size_t)row * 8 + col] = t + a.in[I_BIG][col]; else LF[(size_t)row * 8 + col - 8] = logsigmoid_f(t + a.in[I_BFG][col - 8]); }
        }
    }
    if (GATES) __syncthreads();
}
__device__ __forceinline__ void final_norm_phase(const Args& a, const Frame& F) {
    f32x4 nwv[4];
#pragma unroll
    for (int j = 0; j < 4; ++j) nwv[j] = ((const f32x4*)a.in[I_NFIN])[F.lane + 64 * j];
    for (int row = F.gw; row < MROWS; row += F.ngw) {
        f32x4* xr = (f32x4*)(a.out + (size_t)row * D); f32x4 v[4]; float ss = 0.f;
#pragma unroll
        for (int j = 0; j < 4; ++j) { v[j] = xr[F.lane + 64 * j]; ss += (v[j].x * v[j].x + v[j].y * v[j].y) + (v[j].z * v[j].z + v[j].w * v[j].w); }
        const float rstd = 1.f / sqrtf(wave_sum(ss) * (1.f / D) + EPS_RMS);
#pragma unroll
        for (int j = 0; j < 4; ++j) xr[F.lane + 64 * j] = v[j] * rstd * nwv[j];
    }
}

using pg8::f32x4; using pg8::Unit; using pg8::cvt_pk_bf16;
struct EpiSwiGLU {
    static constexpr bool PERM = true, AFTER_DRAIN = false; bf16* H;
    __device__ __forceinline__ void operator()(const pg8::f32x4 (&acc)[2][2][4][2], const Unit& u, int wr, int wc, int fr, int fq) const {
        const int row0 = u.pm * 256 + wr * 64 + fr, col0 = u.pn * 128 + wc * 32 + 8 * fq;
#pragma unroll
        for (int ai = 0; ai < 2; ++ai)
#pragma unroll
            for (int m = 0; m < 4; ++m) { bf16* rowp = H + (size_t)(row0 + ai * 128 + m * 16) * FF + col0;
                const pg8::f32x4 g0 = acc[ai][0][m][0], g1 = acc[ai][0][m][1], u0 = acc[ai][1][m][0], u1 = acc[ai][1][m][1];
                v4u w; w.x = cvt_pk_bf16(silu_f(g0[0]) * u0[0], silu_f(g0[1]) * u0[1]); w.y = cvt_pk_bf16(silu_f(g0[2]) * u0[2], silu_f(g0[3]) * u0[3]);
                w.z = cvt_pk_bf16(silu_f(g1[0]) * u1[0], silu_f(g1[1]) * u1[1]); w.w = cvt_pk_bf16(silu_f(g1[2]) * u1[2], silu_f(g1[3]) * u1[3]);
                *(v4u*)rowp = w; }
    }
};
template <int MT> struct EpiResid {
    static constexpr bool PERM = false, AFTER_DRAIN = false; const float* base0; const float* base1; float* X; const float* gate; float scale;
    __device__ __forceinline__ void operator()(const pg8::f32x4 (&acc)[2][2][MT][2], const Unit& u, int wr, int wc, int fr, int fq) const {
        const int row0 = u.pm * (MT * 64) + wr * (MT * 16) + fr, col0 = u.pn * 256 + wc * 32 + 4 * fq;
#pragma unroll
        for (int ai = 0; ai < 2; ++ai)
#pragma unroll
            for (int m = 0; m < MT; ++m) { const int row = row0 + ai * (MT * 32) + m * 16; const float* gp = gate + mod_row(row) * MODW + col0;
                const float* bp = (row < NCTX ? base0 + (size_t)row * D : base1 + (size_t)(row - NCTX) * D) + col0; float* xp = X + (size_t)row * D + col0;
#pragma unroll
                for (int bj = 0; bj < 2; ++bj)
#pragma unroll
                    for (int n = 0; n < 2; ++n) { const pg8::f32x4 b = *(const pg8::f32x4*)(bp + bj * 128 + n * 16), gv = *(const pg8::f32x4*)(gp + bj * 128 + n * 16);
                        *(pg8::f32x4*)(xp + bj * 128 + n * 16) = b + gv * scale * acc[ai][bj][m][n]; } }
    }
};
struct EpiProjA {
    static constexpr bool PERM = true, AFTER_DRAIN = false; bf16* P; const float2* rope;
    __device__ __forceinline__ void operator()(const pg8::f32x4 (&acc)[2][2][4][2], const Unit& u, int wr, int wc, int fr, int fq) const {
        const int row0 = u.pm * 256 + wr * 64 + fr;
        if (u.pn < 4) {
            const bool isk = u.pn >= 2, lat = u.pm >= 16; const float scl = isk ? 0.08838834764831845f : 1.f; const int q4 = 4 * wc + fq;
#pragma unroll
            for (int ai = 0; ai < 2; ++ai)
#pragma unroll
                for (int m = 0; m < 4; ++m) { const int row = row0 + ai * 128 + m * 16; const int t = (row - NCTX) & 1023;
#pragma unroll
                    for (int bj = 0; bj < 2; ++bj) { const int hh = 2 * (u.pn & 1) + bj; bf16* op = P + (size_t)row * PA_LD + (isk ? C_RK : C_RQ) + 128 * hh + 4 * q4;
                        pg8::f32x4 x1 = acc[ai][bj][m][0] * scl, x2 = acc[ai][bj][m][1] * scl;
                        if (lat) { const float2* cs = rope + t * 64 + 4 * q4;
#pragma unroll
                            for (int j = 0; j < 4; ++j) { const float2 c = cs[j]; const float a1 = x1[j], a2 = x2[j]; x1[j] = a1 * c.x - a2 * c.y; x2[j] = a2 * c.x + a1 * c.y; } }
                        v2u w1, w2; w1.x = cvt_pk_bf16(x1[0], x1[1]); w1.y = cvt_pk_bf16(x1[2], x1[3]); w2.x = cvt_pk_bf16(x2[0], x2[1]); w2.y = cvt_pk_bf16(x2[2], x2[3]);
                        *(v2u*)op = w1; *(v2u*)(op + 64) = w2; } }
        } else {
            const bool sg = u.pn >= 14; const int col0 = u.pn * 256 + wc * 32 + 8 * fq;
#pragma unroll
            for (int ai = 0; ai < 2; ++ai)
#pragma unroll
                for (int m = 0; m < 4; ++m) { bf16* rowp = P + (size_t)(row0 + ai * 128 + m * 16) * PA_LD + col0;
#pragma unroll
                    for (int bj = 0; bj < 2; ++bj) { pg8::f32x4 v0 = acc[ai][bj][m][0], v1 = acc[ai][bj][m][1];
                        if (sg) {
#pragma unroll
                            for (int j = 0; j < 4; ++j) { v0[j] = sigmoid_f(v0[j]); v1[j] = sigmoid_f(v1[j]); } }
                        v4u w; w.x = cvt_pk_bf16(v0[0], v0[1]); w.y = cvt_pk_bf16(v0[2], v0[3]); w.z = cvt_pk_bf16(v1[0], v1[1]); w.w = cvt_pk_bf16(v1[2], v1[3]);
                        *(v4u*)(rowp + bj * 128) = w; } }
        }
    }
};
template <int MT> struct EpiProjB {
    static constexpr bool PERM = true, AFTER_DRAIN = false; bf16* P; bf16* BG;
    __device__ __forceinline__ void operator()(const pg8::f32x4 (&acc)[2][2][MT][2], const Unit& u, int wr, int wc, int fr, int fq) const {
        const int row0 = u.pm * (MT * 64) + wr * (MT * 16) + fr;
#pragma unroll
        for (int ai = 0; ai < 2; ++ai)
#pragma unroll
            for (int m = 0; m < MT; ++m) { const int row = row0 + ai * (MT * 32) + m * 16;
#pragma unroll
                for (int bj = 0; bj < 2; ++bj) { pg8::f32x4 v0 = acc[ai][bj][m][0], v1 = acc[ai][bj][m][1];
                    if (u.pn < 4) { bf16* p = P + (size_t)row * PA_LD + C_RV + u.pn * 256 + bj * 128 + wc * 32 + 8 * fq; const v4u r = *(const v4u*)p;
                        v4u w; w.x = cvt_pk_bf16(bflo(r.x) * silu_f(v0[0]), bfhi(r.x) * silu_f(v0[1])); w.y = cvt_pk_bf16(bflo(r.y) * silu_f(v0[2]), bfhi(r.y) * silu_f(v0[3]));
                        w.z = cvt_pk_bf16(bflo(r.z) * silu_f(v1[0]), bfhi(r.z) * silu_f(v1[1])); w.w = cvt_pk_bf16(bflo(r.w) * silu_f(v1[2]), bfhi(r.w) * silu_f(v1[3]));
                        *(v4u*)p = w;
                    } else { bf16* p = BG + (size_t)row * 2048 + (u.pn - 4) * 256 + bj * 128 + wc * 32 + 8 * fq;
                        v4u w; w.x = cvt_pk_bf16(sigmoid_f(v0[0]), sigmoid_f(v0[1])); w.y = cvt_pk_bf16(sigmoid_f(v0[2]), sigmoid_f(v0[3]));
                        w.z = cvt_pk_bf16(sigmoid_f(v1[0]), sigmoid_f(v1[1])); w.w = cvt_pk_bf16(sigmoid_f(v1[2]), sigmoid_f(v1[3]));
                        *(v4u*)p = w; } } }
    }
};
template <bool SECOND, int MT> struct EpiMerge {
    static constexpr bool PERM = true, AFTER_DRAIN = false; const bf16* BG; bf16* T1; bf16* OUT;
    __device__ __forceinline__ void operator()(const pg8::f32x4 (&acc)[2][2][MT][2], const Unit& u, int wr, int wc, int fr, int fq) const {
        const int row0 = u.pm * (MT * 64) + wr * (MT * 16) + fr;
#pragma unroll
        for (int ai = 0; ai < 2; ++ai)
#pragma unroll
            for (int m = 0; m < MT; ++m) { const int row = row0 + ai * (MT * 32) + m * 16;
#pragma unroll
                for (int bj = 0; bj < 2; ++bj) { const int col = u.pn * 256 + bj * 128 + wc * 32 + 8 * fq; const pg8::f32x4 v0 = acc[ai][bj][m][0], v1 = acc[ai][bj][m][1];
                    const v4u g = *(const v4u*)(BG + (size_t)row * 2048 + (SECOND ? 1024 : 0) + col);
                    float o[8] = {bflo(g.x) * v0[0], bfhi(g.x) * v0[1], bflo(g.y) * v0[2], bfhi(g.y) * v0[3], bflo(g.z) * v1[0], bfhi(g.z) * v1[1], bflo(g.w) * v1[2], bfhi(g.w) * v1[3]};
                    if (SECOND) { const v4u t = *(const v4u*)(T1 + (size_t)row * D + col);
                        o[0] += bflo(t.x); o[1] += bfhi(t.x); o[2] += bflo(t.y); o[3] += bfhi(t.y); o[4] += bflo(t.z); o[5] += bfhi(t.z); o[6] += bflo(t.w); o[7] += bfhi(t.w); }
                    v4u w; w.x = cvt_pk_bf16(o[0], o[1]); w.y = cvt_pk_bf16(o[2], o[3]); w.z = cvt_pk_bf16(o[4], o[5]); w.w = cvt_pk_bf16(o[6], o[7]);
                    *(v4u*)((SECOND ? OUT : T1) + (size_t)row * D + col) = w; } }
    }
};

__device__ __forceinline__ void chunk_info(int gc, int& n, int& N) { if (gc < 32) { n = gc & 1; N = 2; } else { n = (gc - 32) & 7; N = 8; } }
__device__ __forceinline__ size_t st_idx(int gc, int h, int dir) { return (size_t)((gc * 4 + h) * 2 + dir); }

__device__ __forceinline__ float conv_silu(const bf16* PA, const float* cw, const float* cb, int row, int col, int ch, bool first, bool last) {
    const bf16* p = PA + (size_t)row * PA_LD + col;
    float y = cb[ch] + cw[1024 + ch] * bf2f(p[0]);
    if (!first) y += cw[ch] * bf2f(p[-PA_LD]);
    if (!last) y += cw[2048 + ch] * bf2f(p[PA_LD]);
    return silu_f(y);
}

__device__ __forceinline__ void p7_scalar(const Args& a, const Frame& F) {
    bf16* RS = (bf16*)(a.ws + WS_RS); bf16* MC = (bf16*)(a.ws + WS_MC); float* MN = (float*)(a.ws + WS_MN); float* MS = (float*)(a.ws + WS_MS);
    const int gt = F.bid * 512 + F.tid, ngt = F.G * 512;
    for (long e = gt; e < 24L * 4 * 2 * 32768; e += ngt) {
        const int idx = (int)(e & 32767), sh = (int)(e >> 15), dir = sh & 1, h = (sh >> 1) & 3, s = sh >> 3; const int ev = idx >> 7, d = idx & 127;
        const bool lat = s >= 16; const int N = lat ? 8 : 2, gc0 = lat ? 32 + 8 * (s - 16) : 2 * s;
        const float G = expf(128.f * logsigmoid_f(a.in[I_DECAY][dir * 4 + h]));
        float acc = lat ? a.in[I_SRET][((size_t)(((s - 16) * 2 + dir) * 4 + h)) * 32768 + d * 256 + ev] : 0.f;
        for (int st = 0; st < N; ++st) { const int n = dir ? N - 1 - st : st; bf16* p = RS + st_idx(gc0 + n, h, dir) * 32768 + idx; const float t = bf2f(*p); *p = (bf16)f2bf(acc); acc = G * acc + t; }
        if (!lat) a.out[OUT_SRET + ((size_t)((s * 2 + dir) * 4 + h)) * 32768 + d * 256 + ev] = acc;
    }
    for (long e = gt; e < 24L * 4 * 2 * 16384; e += ngt) {
        const int idx = (int)(e & 16383), sh = (int)(e >> 14), dir = sh & 1, h = (sh >> 1) & 3, s = sh >> 3;
        const bool lat = s >= 16; const int N = lat ? 8 : 2, gc0 = lat ? 32 + 8 * (s - 16) : 2 * s; const int sidx = lat ? ((s - 16) * 2 + dir) * 4 + h : 0;
        float m = lat ? a.in[I_SM][sidx] : 0.f; float C = lat ? a.in[I_SC][(size_t)sidx * 16384 + idx] : 0.f; float nv = (lat && idx < 128) ? a.in[I_SN][sidx * 128 + idx] : 0.f;
        for (int st = 0; st < N; ++st) { const int n = dir ? N - 1 - st : st; const size_t si = st_idx(gc0 + n, h, dir);
            const float ml = MS[si * 4 + 0], bl = MS[si * 4 + 1]; const float mn = fmaxf(bl + m, ml), a1 = expf(bl + m - mn), a2 = expf(ml - mn);
            bf16* p = MC + si * 16384 + idx; const float t = bf2f(*p); *p = (bf16)f2bf(C); C = a1 * C + a2 * t;
            if (idx < 128) { float* q = MN + si * 128 + idx; const float tn = *q; *q = nv; nv = a1 * nv + a2 * tn; }
            if (idx == 0) MS[si * 4 + 2] = m;
            m = mn; }
        if (!lat) { const int o = (s * 2 + dir) * 4 + h; a.out[OUT_SC + (size_t)o * 16384 + idx] = C; if (idx < 128) a.out[OUT_SN + o * 128 + idx] = nv; if (idx == 0) a.out[OUT_SM + o] = m; }
    }
}


typedef short bf16x8 __attribute__((ext_vector_type(8)));
typedef short s16x4 __attribute__((ext_vector_type(4)));
#define MFMA16(a, b, c) __builtin_amdgcn_mfma_f32_16x16x32_bf16(a, b, c, 0, 0, 0)
constexpr float KSCALE = 0.08838834764831845f;
constexpr int LQ = 136, LV = 264;

__device__ __forceinline__ bf16x8 frag_row(const LAS bf16* T, int LD, int r0, int k0, int lane) { return *(const LAS bf16x8*)(T + (r0 + (lane & 15)) * LD + k0 + 8 * (lane >> 4)); }
__device__ __forceinline__ bf16x8 frag_row_g(const bf16* T, int LD, int r0, int k0, int lane) { return *(const bf16x8*)(T + (size_t)(r0 + (lane & 15)) * LD + k0 + 8 * (lane >> 4)); }
__device__ __forceinline__ bf16x8 frag_tr(const LAS bf16* T, int LD, int k0, int n0, int lane) {
    const LAS bf16* p = T + (k0 + 8 * (lane >> 4) + ((lane & 15) >> 2)) * LD + n0 + 4 * (lane & 3);
    const s16x4 lo = __builtin_amdgcn_ds_read_tr16_b64_v4i16((LAS s16x4*)p), hi = __builtin_amdgcn_ds_read_tr16_b64_v4i16((LAS s16x4*)(p + 4 * LD));
    return (bf16x8){lo[0], lo[1], lo[2], lo[3], hi[0], hi[1], hi[2], hi[3]};
}
__device__ __forceinline__ void unpack8(const v4u v, float (&f)[8]) { f[0] = bflo(v.x); f[1] = bfhi(v.x); f[2] = bflo(v.y); f[3] = bfhi(v.y); f[4] = bflo(v.z); f[5] = bfhi(v.z); f[6] = bflo(v.w); f[7] = bfhi(v.w); }
__device__ __forceinline__ v4u pack8(const float (&f)[8]) { v4u w; w.x = pk2(f[0], f[1]); w.y = pk2(f[2], f[3]); w.z = pk2(f[4], f[5]); w.w = pk2(f[6], f[7]); return w; }
template <int W, int LD> __device__ __forceinline__ void stage_tile(LAS bf16* T, const bf16* src, int ld_src, int tid) {
    constexpr int CPR = W / 8, NIT = 128 * CPR / 512; v4u t[NIT];
#pragma unroll
    for (int i = 0; i < NIT; ++i) { const int c = tid + 512 * i, r = c / CPR, cc = c % CPR; t[i] = *(const v4u*)(src + (size_t)r * ld_src + cc * 8); }
#pragma unroll
    for (int i = 0; i < NIT; ++i) { const int c = tid + 512 * i, r = c / CPR, cc = c % CPR; *(LAS v4u*)(T + r * LD + cc * 8) = t[i]; }
}
struct ConvW { float w0[8], w1[8], w2[8], b[8]; };
__device__ __forceinline__ void conv_load(ConvW& c, const float* cw, const float* cb, int ch) {
#pragma unroll
    for (int i = 0; i < 8; ++i) { c.w0[i] = cw[ch + i]; c.w1[i] = cw[1024 + ch + i]; c.w2[i] = cw[2048 + ch + i]; c.b[i] = cb[ch + i]; }
}
struct ConvX { v4u x0, xm, xp; };
__device__ __forceinline__ void conv_fetch(ConvX& x, const bf16* p, bool first, bool last) {
    const v4u z = {0u, 0u, 0u, 0u}; x.x0 = *(const v4u*)p; x.xm = first ? z : *(const v4u*)(p - PA_LD); x.xp = last ? z : *(const v4u*)(p + PA_LD);
}
__device__ __forceinline__ void conv_apply(const ConvW& c, const ConvX& x, float scale, float (&y)[8]) {
    float f0[8], fm[8], fp[8]; unpack8(x.x0, f0); unpack8(x.xm, fm); unpack8(x.xp, fp);
#pragma unroll
    for (int i = 0; i < 8; ++i) y[i] = silu_f(c.b[i] + c.w0[i] * fm[i] + c.w1[i] * f0[i] + c.w2[i] * fp[i]) * scale;
}


__device__ __forceinline__ float gate_scan(const LAS float* lfd, const LAS float* igd, LAS float* bd, int dir, int lane, float& pm0, float& pm1, int& j0, int& j1, float& b0, float& b1) {
    j0 = dir ? 127 - 2 * lane : 2 * lane; j1 = dir ? 126 - 2 * lane : 2 * lane + 1;
    const float x0 = lfd[j0], x1 = lfd[j1], s1 = x0 + x1; float incl = s1;
#pragma unroll
    for (int o = 1; o < 64; o <<= 1) { const float t = __shfl_up(incl, o); if (lane >= o) incl += t; }
    const float excl = incl - s1; b0 = excl + x0; b1 = excl + s1; bd[j0] = b0; bd[j1] = b1;
    const float y0 = igd[j0] - b0, y1 = igd[j1] - b1, m1 = fmaxf(y0, y1); float pmx = m1;
#pragma unroll
    for (int o = 1; o < 64; o <<= 1) { const float t = __shfl_up(pmx, o); if (lane >= o) pmx = fmaxf(pmx, t); }
    float pex = __shfl_up(pmx, 1); if (lane == 0) pex = -3.0e38f;
    pm0 = fmaxf(pex, y0); pm1 = fmaxf(pex, m1);
    return __shfl(incl, 63);
}

__device__ __forceinline__ void p6_mfma(const Args& a, int tid_in, int bid, int G, LAS unsigned char* L) {
    const bf16* PA = (const bf16*)(a.ws + WS_PA); bf16* RS = (bf16*)(a.ws + WS_RS); bf16* MC = (bf16*)(a.ws + WS_MC);
    float* MN = (float*)(a.ws + WS_MN); float* MS = (float*)(a.ws + WS_MS);
    const float* IG = (const float*)(a.ws + WS_IG); const float* LF = (const float*)(a.ws + WS_LF);
    for (int it = bid; it < 2 * NCHUNK * 4; it += G) {
        int tid = tid_in; asm volatile("" : "+v"(tid));
        const int lane = tid & 63, wave = __builtin_amdgcn_readfirstlane(tid >> 6);
        const int branch = it / (NCHUNK * 4), gc = (it % (NCHUNK * 4)) >> 2, h = it & 3, row0 = gc * CH; int n, N; chunk_info(gc, n, N);
        __syncthreads();
        if (branch == 0) {
            LAS bf16* V_l = (LAS bf16*)L; LAS bf16* Kf = (LAS bf16*)(L + 67584); LAS bf16* Kb = (LAS bf16*)(L + 67584 + 34816);
            const float lg0 = logsigmoid_f(a.in[I_DECAY][h]), lg1 = logsigmoid_f(a.in[I_DECAY][4 + h]);
            stage_tile<256, LV>(V_l, PA + (size_t)row0 * PA_LD + C_RV + h * 256, PA_LD, tid);
            for (int c = tid; c < 128 * 16; c += 512) { const int j = c >> 4, cc = c & 15; float f[8], g[8];
                unpack8(*(const v4u*)(PA + (size_t)(row0 + j) * PA_LD + C_RK + h * 128 + cc * 8), f);
                const float wf = __expf(lg0 * (float)(127 - j)), wb = __expf(lg1 * (float)j);
#pragma unroll
                for (int i = 0; i < 8; ++i) { g[i] = f[i] * wb; f[i] *= wf; }
                *(LAS v4u*)(Kf + j * LQ + cc * 8) = pack8(f); *(LAS v4u*)(Kb + j * LQ + cc * 8) = pack8(g); }
            __syncthreads();
#pragma unroll 1
            for (int dir = 0; dir < 2; ++dir) { const LAS bf16* Kd = dir ? Kb : Kf; pg8::f32x4 acc[2][8];
#pragma unroll
                for (int m = 0; m < 2; ++m)
#pragma unroll
                    for (int nn = 0; nn < 8; ++nn) acc[m][nn] = (pg8::f32x4){0.f, 0.f, 0.f, 0.f};
#pragma unroll 1
                for (int k0 = 0; k0 < 128; k0 += 32) { bf16x8 af[2];
#pragma unroll
                    for (int m = 0; m < 2; ++m) af[m] = frag_tr(V_l, LV, k0, wave * 32 + m * 16, lane);
#pragma unroll
                    for (int nn = 0; nn < 8; ++nn) { const bf16x8 bfr = frag_tr(Kd, LQ, k0, nn * 16, lane);
#pragma unroll
                        for (int m = 0; m < 2; ++m) acc[m][nn] = MFMA16(bfr, af[m], acc[m][nn]); } }
                bf16* out = RS + st_idx(gc, h, dir) * 32768;
#pragma unroll
                for (int m = 0; m < 2; ++m)
#pragma unroll
                    for (int nn = 0; nn < 8; ++nn) { v2u w; w.x = cvt_pk_bf16(acc[m][nn][0], acc[m][nn][1]); w.y = cvt_pk_bf16(acc[m][nn][2], acc[m][nn][3]);
                        *(v2u*)(out + (wave * 32 + m * 16 + (lane & 15)) * 128 + nn * 16 + 4 * (lane >> 4)) = w; }
            }
        } else {
            LAS bf16* V_l = (LAS bf16*)L; LAS bf16* Kf = (LAS bf16*)(L + 34816); LAS bf16* Kb = (LAS bf16*)(L + 2 * 34816);
            LAS float* sml = (LAS float*)(L + 3 * 34816); LAS float* lfs = sml; LAS float* igs = sml + 256; LAS float* bs = sml + 512; LAS float* ws_ = sml + 768;
            stage_tile<128, LQ>(V_l, PA + (size_t)row0 * PA_LD + C_MV + h * 128, PA_LD, tid);
            if (tid < 256) { const int dir = tid >> 7, j = tid & 127; lfs[tid] = LF[(size_t)(row0 + j) * 8 + dir * 4 + h]; igs[tid] = IG[(size_t)(row0 + j) * 8 + dir * 4 + h]; }
            __syncthreads();
            if (wave < 2) { const int dir = wave; float pm0, pm1, b0, b1; int j0, j1;
                const float blast = gate_scan(lfs + dir * 128, igs + dir * 128, bs + dir * 128, dir, lane, pm0, pm1, j0, j1, b0, b1);
                const float g0 = blast - b0 + igs[dir * 128 + j0], g1 = blast - b1 + igs[dir * 128 + j1]; float ml = fmaxf(g0, g1);
#pragma unroll
                for (int o = 1; o < 64; o <<= 1) ml = fmaxf(ml, __shfl_xor(ml, o));
                ws_[dir * 128 + j0] = expf(g0 - ml); ws_[dir * 128 + j1] = expf(g1 - ml);
                if (lane == 0) { MS[st_idx(gc, h, dir) * 4 + 0] = ml; MS[st_idx(gc, h, dir) * 4 + 1] = blast; } }
            __syncthreads();
            { ConvW cwv; const int cc = tid & 15; conv_load(cwv, a.in[I_CONVW], a.in[I_CONVB], 512 + h * 128 + cc * 8); ConvX cx[4];
#pragma unroll
              for (int i4 = 0; i4 < 4; ++i4) { const int j = (tid + 512 * i4) >> 4; conv_fetch(cx[i4], PA + (size_t)(row0 + j) * PA_LD + C_MK + h * 128 + cc * 8, n == 0 && j == 0, n == N - 1 && j == 127); }
#pragma unroll
              for (int i4 = 0; i4 < 4; ++i4) { const int j = (tid + 512 * i4) >> 4; float f[8], g[8];
                  conv_apply(cwv, cx[i4], KSCALE, f);
                  const float wf = ws_[j], wb = ws_[128 + j];
#pragma unroll
                  for (int i = 0; i < 8; ++i) { const float kq = bf2f((bf16)f2bf(f[i])); g[i] = kq * wb; f[i] = kq * wf; }
                  *(LAS v4u*)(Kf + j * LQ + cc * 8) = pack8(f); *(LAS v4u*)(Kb + j * LQ + cc * 8) = pack8(g); } }
            __syncthreads();
            if (tid < 256) { const int dir = tid >> 7, k = tid & 127; const LAS bf16* Kd = dir ? Kb : Kf; float s = 0.f;
#pragma unroll 16
                for (int j = 0; j < 128; ++j) s += bf2f(Kd[j * LQ + k]);
                MN[st_idx(gc, h, dir) * 128 + k] = s; }
#pragma unroll 1
            for (int dir = 0; dir < 2; ++dir) { const LAS bf16* Kd = dir ? Kb : Kf; pg8::f32x4 acc[8];
#pragma unroll
                for (int nn = 0; nn < 8; ++nn) acc[nn] = (pg8::f32x4){0.f, 0.f, 0.f, 0.f};
#pragma unroll 1
                for (int k0 = 0; k0 < 128; k0 += 32) { const bf16x8 af = frag_tr(V_l, LQ, k0, wave * 16, lane);
#pragma unroll
                    for (int nn = 0; nn < 8; ++nn) { const bf16x8 bfr = frag_tr(Kd, LQ, k0, nn * 16, lane); acc[nn] = MFMA16(bfr, af, acc[nn]); } }
                bf16* out = MC + st_idx(gc, h, dir) * 16384;
#pragma unroll
                for (int nn = 0; nn < 8; ++nn) { v2u w; w.x = cvt_pk_bf16(acc[nn][0], acc[nn][1]); w.y = cvt_pk_bf16(acc[nn][2], acc[nn][3]);
                    *(v2u*)(out + (wave * 16 + (lane & 15)) * 128 + nn * 16 + 4 * (lane >> 4)) = w; }
            }
        }
    }
}

template <int MODE> __device__ __forceinline__ void p8_mfma(const Args& a, int tid_in, int bid, int G, LAS unsigned char* L) {
    bf16* PA = (bf16*)(a.ws + WS_PA); const bf16* RS = (const bf16*)(a.ws + WS_RS); const bf16* MC = (const bf16*)(a.ws + WS_MC);
    const float* MN = (const float*)(a.ws + WS_MN); const float* MS = (const float*)(a.ws + WS_MS);
    const float* IG = (const float*)(a.ws + WS_IG); const float* LF = (const float*)(a.ws + WS_LF);
    LAS bf16* Q_l = (LAS bf16*)L; LAS bf16* K_l = (LAS bf16*)(L + 34816); LAS bf16* P_l = K_l; LAS bf16* V_l = (LAS bf16*)(L + 2 * 34816);
    for (int it = bid; it < 2 * NCHUNK * 4; it += G) {
        int tid = tid_in; asm volatile("" : "+v"(tid));
        const int lane = tid & 63, wave = __builtin_amdgcn_readfirstlane(tid >> 6), fr = lane & 15, fq = lane >> 4;
        const int branch = it / (NCHUNK * 4), gc = (it % (NCHUNK * 4)) >> 2, h = it & 3, row0 = gc * CH; int n, N; chunk_info(gc, n, N);
        const bool lat = gc >= 32;
        if (!(MODE & (branch ? 2 : 1))) continue;
        __syncthreads();
        if (branch == 0) {
            LAS float* red = (LAS float*)(L + 2 * 34816 + 67584);
            const float lg0 = logsigmoid_f(a.in[I_DECAY][h]), lg1 = logsigmoid_f(a.in[I_DECAY][4 + h]);
            const bool hasf = lat || n > 0, hasb = lat || n < N - 1;
            bf16x8 sfr[2][4][2];
#pragma unroll
            for (int dir = 0; dir < 2; ++dir) { const bf16* S = RS + st_idx(gc, h, dir) * 32768;
                if (dir ? hasb : hasf) {
#pragma unroll
                    for (int ks = 0; ks < 4; ++ks) { sfr[dir][ks][0] = frag_row_g(S, 128, wave * 32, ks * 32, lane); sfr[dir][ks][1] = frag_row_g(S, 128, wave * 32 + 16, ks * 32, lane); } }
                else {
#pragma unroll
                    for (int ks = 0; ks < 4; ++ks) { sfr[dir][ks][0] = (bf16x8){0, 0, 0, 0, 0, 0, 0, 0}; sfr[dir][ks][1] = sfr[dir][ks][0]; } } }
            stage_tile<128, LQ>(Q_l, PA + (size_t)row0 * PA_LD + C_RQ + h * 128, PA_LD, tid);
            stage_tile<128, LQ>(K_l, PA + (size_t)row0 * PA_LD + C_RK + h * 128, PA_LD, tid);
            stage_tile<256, LV>(V_l, PA + (size_t)row0 * PA_LD + C_RV + h * 256, PA_LD, tid);
            __syncthreads();
            {
                pg8::f32x4 sc[8];
#pragma unroll
                for (int m = 0; m < 8; ++m) sc[m] = (pg8::f32x4){0.f, 0.f, 0.f, 0.f};
#pragma unroll 1
                for (int k0 = 0; k0 < 128; k0 += 32) { const bf16x8 bfr = frag_row(K_l, LQ, wave * 16, k0, lane);
#pragma unroll
                    for (int m = 0; m < 8; ++m) sc[m] = MFMA16(bfr, frag_row(Q_l, LQ, m * 16, k0, lane), sc[m]); }
                __syncthreads();
#pragma unroll
                for (int m = 0; m < 8; ++m) { const int i = m * 16 + fr; float p[4];
#pragma unroll
                    for (int r = 0; r < 4; ++r) { const int j = wave * 16 + 4 * fq + r; const float dm = i > j ? __expf(lg0 * (float)(i - j)) : (i < j ? __expf(lg1 * (float)(j - i)) : 2.f); p[r] = sc[m][r] * dm; }
                    v2u w; w.x = cvt_pk_bf16(p[0], p[1]); w.y = cvt_pk_bf16(p[2], p[3]); *(LAS v2u*)(P_l + i * LQ + wave * 16 + 4 * fq) = w; }
            }
            __syncthreads();
            pg8::f32x4 accR[8][2];
#pragma unroll
            for (int m = 0; m < 8; ++m) { accR[m][0] = (pg8::f32x4){0.f, 0.f, 0.f, 0.f}; accR[m][1] = (pg8::f32x4){0.f, 0.f, 0.f, 0.f}; }
#pragma unroll
            for (int dir = 0; dir < 2; ++dir) {
                if (!(dir ? hasb : hasf)) continue;
#pragma unroll
                for (int ks = 0; ks < 4; ++ks) {
#pragma unroll
                    for (int m = 0; m < 8; ++m) { const bf16x8 af = frag_row(Q_l, LQ, m * 16, ks * 32, lane); accR[m][0] = MFMA16(sfr[dir][ks][0], af, accR[m][0]); accR[m][1] = MFMA16(sfr[dir][ks][1], af, accR[m][1]); } }
#pragma unroll
                for (int m = 0; m < 8; ++m) { const float i = (float)(m * 16 + fr); const float ef = lg0 * (i + 1.f), eb = lg1 * (128.f - i);
                    const float wq = dir ? __expf(eb) : (hasb ? __expf(ef - eb) : __expf(ef));
                    accR[m][0] *= wq; accR[m][1] *= wq; }
            }
#pragma unroll 1
            for (int k0 = 0; k0 < 128; k0 += 32) { const bf16x8 b0 = frag_tr(V_l, LV, k0, wave * 32, lane), b1 = frag_tr(V_l, LV, k0, wave * 32 + 16, lane);
#pragma unroll
                for (int m = 0; m < 8; ++m) { const bf16x8 af = frag_row(P_l, LQ, m * 16, k0, lane); accR[m][0] = MFMA16(b0, af, accR[m][0]); accR[m][1] = MFMA16(b1, af, accR[m][1]); } }
#pragma unroll
            for (int m = 0; m < 8; ++m) { float s1 = 0.f, s2 = 0.f;
#pragma unroll
                for (int nn = 0; nn < 2; ++nn)
#pragma unroll
                    for (int r = 0; r < 4; ++r) { const float x = accR[m][nn][r]; s1 += x; s2 += x * x; }
                s1 += __shfl_xor(s1, 16); s1 += __shfl_xor(s1, 32); s2 += __shfl_xor(s2, 16); s2 += __shfl_xor(s2, 32);
                if (fq == 0) { red[((m * 16 + fr) * 8 + wave) * 2] = s1; red[((m * 16 + fr) * 8 + wave) * 2 + 1] = s2; } }
            __syncthreads();
            pg8::f32x4 gnv[2];
#pragma unroll
            for (int nn = 0; nn < 2; ++nn) gnv[nn] = *(const pg8::f32x4*)(a.in[I_RETGN] + h * 256 + wave * 32 + nn * 16 + 4 * fq);
#pragma unroll
            for (int m = 0; m < 8; ++m) { const int i = m * 16 + fr; float s1 = 0.f, s2 = 0.f;
#pragma unroll
                for (int w = 0; w < 8; ++w) { s1 += red[(i * 8 + w) * 2]; s2 += red[(i * 8 + w) * 2 + 1]; }
                const float mu = s1 * (1.f / 256.f), rstd = 1.f / sqrtf(fmaxf(s2 * (1.f / 256.f) - mu * mu, 0.f) + EPS_GN);
#pragma unroll
                for (int nn = 0; nn < 2; ++nn) { const pg8::f32x4 y = (accR[m][nn] - mu) * rstd * gnv[nn]; v2u w; w.x = cvt_pk_bf16(y[0], y[1]); w.y = cvt_pk_bf16(y[2], y[3]);
                    *(v2u*)(PA + (size_t)(row0 + i) * PA_LD + C_RV + h * 256 + wave * 32 + nn * 16 + 4 * fq) = w; } }
        } else {
            LAS bf16* Vm = (LAS bf16*)(L + 2 * 34816);
            LAS float* sml = (LAS float*)(L + 3 * 34816);
            LAS float* lfs = sml; LAS float* igs = sml + 256; LAS float* bs = sml + 512; LAS float* mis = sml + 768; LAS float* wis = sml + 1024; LAS float* qns = sml + 1280; LAS float* rds = sml + 1536; LAS float* nps = sml + 1792;
            LAS float* red = sml + 2048;
            const size_t si0 = st_idx(gc, h, 0);
            const bool hasf = lat || n > 0, hasb = lat || n < N - 1;
            bf16x8 cfr[2][4];
#pragma unroll
            for (int dir = 0; dir < 2; ++dir) { const bf16* Cp = MC + (si0 + dir) * 16384;
                if (dir ? hasb : hasf) {
#pragma unroll
                    for (int ks = 0; ks < 4; ++ks) cfr[dir][ks] = frag_row_g(Cp, 128, wave * 16, ks * 32, lane); }
                else {
#pragma unroll
                    for (int ks = 0; ks < 4; ++ks) cfr[dir][ks] = (bf16x8){0, 0, 0, 0, 0, 0, 0, 0}; } }
            {   const int cc = tid & 15; ConvX cx[4], cy[4];
#pragma unroll
                for (int i4 = 0; i4 < 4; ++i4) { const int j = (tid + 512 * i4) >> 4; const bool fi = n == 0 && j == 0, la = n == N - 1 && j == 127;
                    conv_fetch(cx[i4], PA + (size_t)(row0 + j) * PA_LD + C_MQ + h * 128 + cc * 8, fi, la); conv_fetch(cy[i4], PA + (size_t)(row0 + j) * PA_LD + C_MK + h * 128 + cc * 8, fi, la); }
                { ConvW cq; conv_load(cq, a.in[I_CONVW], a.in[I_CONVB], h * 128 + cc * 8);
#pragma unroll
                  for (int i4 = 0; i4 < 4; ++i4) { const int j = (tid + 512 * i4) >> 4; float f[8]; conv_apply(cq, cx[i4], 1.f, f); *(LAS v4u*)(Q_l + j * LQ + cc * 8) = pack8(f); } }
                { ConvW ck; conv_load(ck, a.in[I_CONVW], a.in[I_CONVB], 512 + h * 128 + cc * 8);
#pragma unroll
                  for (int i4 = 0; i4 < 4; ++i4) { const int j = (tid + 512 * i4) >> 4; float f[8]; conv_apply(ck, cy[i4], KSCALE, f); *(LAS v4u*)(K_l + j * LQ + cc * 8) = pack8(f); } } }
            stage_tile<128, LQ>(Vm, PA + (size_t)row0 * PA_LD + C_MV + h * 128, PA_LD, tid);
            if (tid < 256) { const int dir = tid >> 7, j = tid & 127; lfs[tid] = LF[(size_t)(row0 + j) * 8 + dir * 4 + h]; igs[tid] = IG[(size_t)(row0 + j) * 8 + dir * 4 + h]; nps[tid] = MN[(si0 + dir) * 128 + j]; }
            __syncthreads();
            if (wave < 2) { const int dir = wave; float pm0, pm1, b0, b1; int j0, j1;
                (void)gate_scan(lfs + dir * 128, igs + dir * 128, bs + dir * 128, dir, lane, pm0, pm1, j0, j1, b0, b1);
                const float mprev = MS[(si0 + dir) * 4 + 2];
                { const float lin = b0 + mprev, mi = fmaxf(b0 + pm0, lin); mis[dir * 128 + j0] = mi; wis[dir * 128 + j0] = expf(lin - mi); }
                { const float lin = b1 + mprev, mi = fmaxf(b1 + pm1, lin); mis[dir * 128 + j1] = mi; wis[dir * 128 + j1] = expf(lin - mi); } }
            {
                const int i = tid & 127, qq = tid >> 7; float q0 = 0.f, q1 = 0.f;
#pragma unroll
                for (int kk = 0; kk < 16; ++kk) { const unsigned w = *(const LAS unsigned*)(Q_l + i * LQ + 32 * qq + 2 * kk); const float x = bflo(w), y = bfhi(w); const int k = 32 * qq + 2 * kk;
                    q0 += x * nps[k] + y * nps[k + 1]; q1 += x * nps[128 + k] + y * nps[128 + k + 1]; }
                red[(qq * 2 + 0) * 128 + i] = q0; red[(qq * 2 + 1) * 128 + i] = q1; }
            __syncthreads();
            if (tid < 256) { const int dir = tid >> 7, i = tid & 127; qns[tid] = (red[dir * 128 + i] + red[(2 + dir) * 128 + i]) + (red[(4 + dir) * 128 + i] + red[(6 + dir) * 128 + i]); }
            __syncthreads();
            {
                pg8::f32x4 sc[8];
#pragma unroll
                for (int m = 0; m < 8; ++m) sc[m] = (pg8::f32x4){0.f, 0.f, 0.f, 0.f};
#pragma unroll 1
                for (int k0 = 0; k0 < 128; k0 += 32) { const bf16x8 bfr = frag_row(K_l, LQ, wave * 16, k0, lane);
#pragma unroll
                    for (int m = 0; m < 8; ++m) sc[m] = MFMA16(bfr, frag_row(Q_l, LQ, m * 16, k0, lane), sc[m]); }
                pg8::f32x4 s0[8], s1[8];
#pragma unroll
                for (int m = 0; m < 8; ++m) { const int i = m * 16 + fr; const float e0 = bs[i] - mis[i], e1 = bs[128 + i] - mis[128 + i]; float r0 = 0.f, r1 = 0.f;
#pragma unroll
                    for (int r = 0; r < 4; ++r) { const int j = wave * 16 + 4 * fq + r;
                        s0[m][r] = j <= i ? sc[m][r] * __expf(e0 - bs[j] + igs[j]) : 0.f; s1[m][r] = j >= i ? sc[m][r] * __expf(e1 - bs[128 + j] + igs[128 + j]) : 0.f;
                        r0 += s0[m][r]; r1 += s1[m][r]; }
                    r0 += __shfl_xor(r0, 16); r0 += __shfl_xor(r0, 32); r1 += __shfl_xor(r1, 16); r1 += __shfl_xor(r1, 32);
                    if (fq == 0) { red[i * 8 + wave] = r0; red[(128 + i) * 8 + wave] = r1; } }
                __syncthreads();
                if (tid < 256) { float den = 0.f;
#pragma unroll
                    for (int w = 0; w < 8; ++w) den += red[tid * 8 + w];
                    den += wis[tid] * qns[tid]; rds[tid] = 1.f / fmaxf(fabsf(den), expf(-mis[tid])); }
                __syncthreads();
#pragma unroll
                for (int m = 0; m < 8; ++m) { const int i = m * 16 + fr; const float d0 = rds[i], d1 = rds[128 + i];
                    const pg8::f32x4 p = s0[m] * d0 + s1[m] * d1; v2u w; w.x = cvt_pk_bf16(p[0], p[1]); w.y = cvt_pk_bf16(p[2], p[3]); *(LAS v2u*)(P_l + i * LQ + wave * 16 + 4 * fq) = w; }
            }
            __syncthreads();
            pg8::f32x4 accH[8];
#pragma unroll
            for (int m = 0; m < 8; ++m) accH[m] = (pg8::f32x4){0.f, 0.f, 0.f, 0.f};
#pragma unroll
            for (int dir = 0; dir < 2; ++dir) {
                if (!(dir ? hasb : hasf)) continue;
                pg8::f32x4 accX[8];
#pragma unroll
                for (int m = 0; m < 8; ++m) accX[m] = (pg8::f32x4){0.f, 0.f, 0.f, 0.f};
#pragma unroll
                for (int ks = 0; ks < 4; ++ks) {
#pragma unroll
                    for (int m = 0; m < 8; ++m) accX[m] = MFMA16(cfr[dir][ks], frag_row(Q_l, LQ, m * 16, ks * 32, lane), accX[m]); }
#pragma unroll
                for (int m = 0; m < 8; ++m) { const int i = dir * 128 + m * 16 + fr; accH[m] += accX[m] * (wis[i] * rds[i]); }
            }
#pragma unroll 1
            for (int k0 = 0; k0 < 128; k0 += 32) { const bf16x8 bfr = frag_tr(Vm, LQ, k0, wave * 16, lane);
#pragma unroll
                for (int m = 0; m < 8; ++m) accH[m] = MFMA16(bfr, frag_row(P_l, LQ, m * 16, k0, lane), accH[m]); }
            __syncthreads();
#pragma unroll
            for (int m = 0; m < 8; ++m) { const int i = m * 16 + fr; const v2u g = *(const v2u*)(PA + (size_t)(row0 + i) * PA_LD + C_MO + h * 128 + wave * 16 + 4 * fq);
                accH[m][0] *= bflo(g.x); accH[m][1] *= bfhi(g.x); accH[m][2] *= bflo(g.y); accH[m][3] *= bfhi(g.y);
                float s1 = (accH[m][0] + accH[m][1]) + (accH[m][2] + accH[m][3]), s2 = (accH[m][0] * accH[m][0] + accH[m][1] * accH[m][1]) + (accH[m][2] * accH[m][2] + accH[m][3] * accH[m][3]);
                s1 += __shfl_xor(s1, 16); s1 += __shfl_xor(s1, 32); s2 += __shfl_xor(s2, 16); s2 += __shfl_xor(s2, 32);
                if (fq == 0) { red[(i * 8 + wave) * 2] = s1; red[(i * 8 + wave) * 2 + 1] = s2; } }
            __syncthreads();
            const pg8::f32x4 gnv = *(const pg8::f32x4*)(a.in[I_MGN] + h * 128 + wave * 16 + 4 * fq);
#pragma unroll
            for (int m = 0; m < 8; ++m) { const int i = m * 16 + fr; float s1 = 0.f, s2 = 0.f;
#pragma unroll
                for (int w = 0; w < 8; ++w) { s1 += red[(i * 8 + w) * 2]; s2 += red[(i * 8 + w) * 2 + 1]; }
                const float mu = s1 * (1.f / 128.f), rstd = 1.f / sqrtf(fmaxf(s2 * (1.f / 128.f) - mu * mu, 0.f) + EPS_GN);
                const pg8::f32x4 y = (accH[m] - mu) * rstd * gnv; v2u w; w.x = cvt_pk_bf16(y[0], y[1]); w.y = cvt_pk_bf16(y[2], y[3]);
                *(v2u*)(PA + (size_t)(row0 + i) * PA_LD + C_MV + h * 128 + wave * 16 + 4 * fq) = w; }
        }
    }
}

template <int N> __device__ __forceinline__ void scan_ret(bf16* RS, int gc0, int h, int dir, int tile, const float* init, float* fin, float Gd, int lane) {
    const int e0 = 16 * tile + 4 * (lane >> 4), d0 = 8 * (lane & 15);
    float acc[4][8];
#pragma unroll
    for (int dd = 0; dd < 8; ++dd) { pg8::f32x4 v = {0.f, 0.f, 0.f, 0.f}; if (init) v = *(const pg8::f32x4*)(init + (d0 + dd) * 256 + e0); acc[0][dd] = v[0]; acc[1][dd] = v[1]; acc[2][dd] = v[2]; acc[3][dd] = v[3]; }
    v4u t[N][4];
#pragma unroll
    for (int st = 0; st < N; ++st) { const int n = dir ? N - 1 - st : st; const bf16* p = RS + st_idx(gc0 + n, h, dir) * 32768 + e0 * 128 + d0;
#pragma unroll
        for (int ee = 0; ee < 4; ++ee) t[st][ee] = *(const v4u*)(p + ee * 128); }
#pragma unroll
    for (int st = 0; st < N; ++st) { const int n = dir ? N - 1 - st : st; bf16* p = RS + st_idx(gc0 + n, h, dir) * 32768 + e0 * 128 + d0;
#pragma unroll
        for (int ee = 0; ee < 4; ++ee) { float f[8]; unpack8(t[st][ee], f); *(v4u*)(p + ee * 128) = pack8(acc[ee]);
#pragma unroll
            for (int dd = 0; dd < 8; ++dd) acc[ee][dd] = Gd * acc[ee][dd] + f[dd]; } }
    if (fin) {
#pragma unroll
        for (int dd = 0; dd < 8; ++dd) *(pg8::f32x4*)(fin + (d0 + dd) * 256 + e0) = (pg8::f32x4){acc[0][dd], acc[1][dd], acc[2][dd], acc[3][dd]}; }
}
template <int N> __device__ __forceinline__ void scan_ml(bf16* MC, float* MN, float* MS, int gc0, int h, int dir, int vb, const float* iC, const float* in_, float m, float* fC, float* fn, float* fm, int lane) {
    const int row0 = 16 * vb + (lane >> 4), kc = 8 * (lane & 15);
    float C[4][8], nv0 = 0.f, nv1 = 0.f;
#pragma unroll
    for (int r = 0; r < 4; ++r) { pg8::f32x4 v0 = {0.f, 0.f, 0.f, 0.f}, v1 = v0; if (iC) { v0 = *(const pg8::f32x4*)(iC + (row0 + 4 * r) * 128 + kc); v1 = *(const pg8::f32x4*)(iC + (row0 + 4 * r) * 128 + kc + 4); }
#pragma unroll
        for (int i = 0; i < 4; ++i) { C[r][i] = v0[i]; C[r][4 + i] = v1[i]; } }
    if (vb == 0 && in_) { nv0 = in_[lane]; nv1 = in_[lane + 64]; }
    v4u t[N][4]; float mlv[N], blv[N], tn0[N], tn1[N];
#pragma unroll
    for (int st = 0; st < N; ++st) { const int n = dir ? N - 1 - st : st; const size_t si = st_idx(gc0 + n, h, dir); const bf16* p = MC + si * 16384 + row0 * 128 + kc;
        mlv[st] = MS[si * 4 + 0]; blv[st] = MS[si * 4 + 1]; tn0[st] = 0.f; tn1[st] = 0.f; if (vb == 0) { tn0[st] = MN[si * 128 + lane]; tn1[st] = MN[si * 128 + lane + 64]; }
#pragma unroll
        for (int r = 0; r < 4; ++r) t[st][r] = *(const v4u*)(p + 4 * r * 128); }
#pragma unroll
    for (int st = 0; st < N; ++st) { const int n = dir ? N - 1 - st : st; const size_t si = st_idx(gc0 + n, h, dir);
        const float ml = mlv[st], bl = blv[st]; const float mn = fmaxf(bl + m, ml), a1 = expf(bl + m - mn), a2 = expf(ml - mn);
        bf16* p = MC + si * 16384 + row0 * 128 + kc;
#pragma unroll
        for (int r = 0; r < 4; ++r) { float f[8]; unpack8(t[st][r], f); *(v4u*)(p + 4 * r * 128) = pack8(C[r]);
#pragma unroll
            for (int i = 0; i < 8; ++i) C[r][i] = a1 * C[r][i] + a2 * f[i]; }
        if (vb == 0) { float* q = MN + si * 128; const float t0 = tn0[st], t1 = tn1[st]; q[lane] = nv0; q[lane + 64] = nv1; nv0 = a1 * nv0 + a2 * t0; nv1 = a1 * nv1 + a2 * t1;
            if (lane == 0) MS[si * 4 + 2] = m; }
        m = mn; }
    if (fC) {
#pragma unroll
        for (int r = 0; r < 4; ++r) { *(pg8::f32x4*)(fC + (row0 + 4 * r) * 128 + kc) = (pg8::f32x4){C[r][0], C[r][1], C[r][2], C[r][3]}; *(pg8::f32x4*)(fC + (row0 + 4 * r) * 128 + kc + 4) = (pg8::f32x4){C[r][4], C[r][5], C[r][6], C[r][7]}; }
        if (vb == 0) { fn[lane] = nv0; fn[lane + 64] = nv1; if (lane == 0) *fm = m; } }
}
__device__ __forceinline__ void p7_scan(const Args& a, int tid_in, int bid, int G) {
    bf16* RS = (bf16*)(a.ws + WS_RS); bf16* MC = (bf16*)(a.ws + WS_MC); float* MN = (float*)(a.ws + WS_MN); float* MS = (float*)(a.ws + WS_MS);
    int tid = tid_in; asm volatile("" : "+v"(tid));
    const int lane = tid & 63, wave = __builtin_amdgcn_readfirstlane(tid >> 6);
    for (int it = bid * 8 + wave; it < 4608; it += G * 8) {
        int r = it; bool lat = true, ret = true;
        if (r >= 1024) { r -= 1024; ret = false; if (r >= 512) { r -= 512; lat = false; ret = true; if (r >= 2048) { r -= 2048; ret = false; } } }
        if (ret) { const int tile = r & 15, mat = r >> 4, dir = mat & 1, h = (mat >> 1) & 3, sl = mat >> 3; const float Gd = expf(128.f * logsigmoid_f(a.in[I_DECAY][dir * 4 + h]));
            if (lat) scan_ret<8>(RS, 32 + 8 * sl, h, dir, tile, a.in[I_SRET] + (size_t)((sl * 2 + dir) * 4 + h) * 32768, nullptr, Gd, lane);
            else scan_ret<2>(RS, 2 * sl, h, dir, tile, nullptr, a.out + OUT_SRET + (size_t)((sl * 2 + dir) * 4 + h) * 32768, Gd, lane);
        } else { const int vb = r & 7, mat = r >> 3, dir = mat & 1, h = (mat >> 1) & 3, sl = mat >> 3; const int o = (sl * 2 + dir) * 4 + h;
            if (lat) scan_ml<8>(MC, MN, MS, 32 + 8 * sl, h, dir, vb, a.in[I_SC] + (size_t)o * 16384, a.in[I_SN] + o * 128, a.in[I_SM][o], nullptr, nullptr, nullptr, lane);
            else scan_ml<2>(MC, MN, MS, 2 * sl, h, dir, vb, nullptr, nullptr, 0.f, a.out + OUT_SC + (size_t)o * 16384, a.out + OUT_SN + o * 128, a.out + OUT_SM + o, lane);
        }
    }
}

constexpr int NPHASE = 16;
#ifndef MK_PER_PHASE
#define MK_PER_PHASE 0
#endif
#ifndef MIX6
#define MIX6 1
#endif
#ifndef MIX7
#define MIX7 1
#endif
#ifndef MIX8
#define MIX8 1
#endif
#define MIXER_MFMA (MIX6 && MIX7 && MIX8)
#define GEMM_PHASE(EPI, g, S, E) pg8::gemm_phase<EPI, pg8::StaticOrder, true, true, 4>((PG8_LAS unsigned char*)lds, g, S, E)
#define GEMM_PHASE3(EPI, g, S, E) pg8::gemm_phase<EPI, pg8::StaticOrder, true, true, 3>((PG8_LAS unsigned char*)lds, g, S, E)

template <int K> __device__ __forceinline__ void run_phase(const Args& a, const Frame& F, LAS unsigned char* lds) {
    unsigned char* ws = a.ws; const float* mod = (const float*)(ws + WS_MOD);
    bf16* U = (bf16*)(ws + WS_U); bf16* H = (bf16*)(ws + WS_H); bf16* PA = (bf16*)(ws + WS_PA); bf16* BG = (bf16*)(ws + WS_BG); bf16* T1 = (bf16*)(ws + WS_T1);
    float* X = a.out + OUT_Y;
    if constexpr (K == 0) { p0_prologue(a, F); p0_convert(a, F, 0, CV_FFN1, F.gw, F.ngw); }
    if constexpr (K == 1) { norm_phase<false>(a, F, a.in[I_XP], a.in[I_XS], a.in[I_NF1], 0 * D, 1 * D); }
    if constexpr (K == 2) { pg8::Gemm g{U, (const bf16*)(ws + WS_W13A), MROWS, 2 * FF, D, D}; pg8::StaticOrder S; S.init(MROWS, 2 * FF, F.G, F.bid); EpiSwiGLU E{H}; GEMM_PHASE(EpiSwiGLU, g, S, E);
        if (F.bid >= 32) p0_convert(a, F, CV_FFN1, CV_END, (F.bid - 32) * 8 + F.wave, (F.G - 32) * 8); }
    if constexpr (K == 3) { pg8::Gemm g{H, (const bf16*)(ws + WS_W2A), MROWS, D, FF, FF}; pg8::StaticOrder S; S.init(MROWS, D, F.G, F.bid, 192); EpiResid<3> E{a.in[I_XP], a.in[I_XS], X, mod + 2 * D, 0.5f}; GEMM_PHASE3(EpiResid<3>, g, S, E); }
    if constexpr (K == 4) { norm_phase<true>(a, F, X, X + (size_t)NCTX * D, a.in[I_NMIX], 3 * D, 4 * D); }
    if constexpr (K == 5) { pg8::Gemm g{U, (const bf16*)(ws + WS_WIN), MROWS, 4096, D, D}; pg8::StaticOrder S; S.init(MROWS, 4096, F.G, F.bid); EpiProjA E{PA, (const float2*)(ws + WS_ROPE)}; GEMM_PHASE(EpiProjA, g, S, E); }
    if constexpr (K == 6) { p6_mfma(a, F.tid, F.bid, F.G, lds); }
    if constexpr (K == 7) { p7_scan(a, F.tid, F.bid, F.G); }
    if constexpr (K == 8) { p8_mfma<3>(a, F.tid, F.bid, F.G, lds); }
    if constexpr (K == 81) { p8_mfma<1>(a, F.tid, F.bid, F.G, lds); }
    if constexpr (K == 83) { p8_mfma<1 + 4>(a, F.tid, F.bid, F.G, lds); }
    if constexpr (K == 84) { p8_mfma<1 + 8>(a, F.tid, F.bid, F.G, lds); }
    if constexpr (K == 85) { p8_mfma<1 + 16>(a, F.tid, F.bid, F.G, lds); }
    if constexpr (K == 86) { p8_mfma<2 + 32>(a, F.tid, F.bid, F.G, lds); }
    if constexpr (K == 87) { p8_mfma<2 + 64>(a, F.tid, F.bid, F.G, lds); }
    if constexpr (K == 82) { p8_mfma<2>(a, F.tid, F.bid, F.G, lds); }
    if constexpr (K == 9) { pg8::Gemm g{U, (const bf16*)(ws + WS_WIN) + (size_t)4096 * D, MROWS, 3072, D, D}; pg8::StaticOrder S; S.init(MROWS, 3072, F.G, F.bid, 192); EpiProjB<3> E{PA, BG}; GEMM_PHASE3(EpiProjB<3>, g, S, E); }
    if constexpr (K == 10) {
        { pg8::Gemm g{PA + C_RV, (const bf16*)(ws + WS_WR), MROWS, D, D, PA_LD}; pg8::StaticOrder S; S.init(MROWS, D, F.G, F.bid, 192); using EM = EpiMerge<false, 3>; EM E{BG, T1, U}; GEMM_PHASE3(EM, g, S, E); }
        { pg8::Gemm g{PA + C_MV, (const bf16*)(ws + WS_WM), MROWS, D, 512, PA_LD}; pg8::StaticOrder S; S.init(MROWS, D, F.G, F.bid, 192); using EM = EpiMerge<true, 3>; EM E{BG, T1, U}; GEMM_PHASE3(EM, g, S, E); }
    }
    if constexpr (K == 11) { pg8::Gemm g{U, (const bf16*)(ws + WS_WO), MROWS, D, D, D}; pg8::StaticOrder S; S.init(MROWS, D, F.G, F.bid, 192); EpiResid<3> E{X, X + (size_t)NCTX * D, X, mod + 5 * D, 1.0f}; GEMM_PHASE3(EpiResid<3>, g, S, E); }
    if constexpr (K == 12) { norm_phase<false>(a, F, X, X + (size_t)NCTX * D, a.in[I_NF2], 6 * D, 7 * D); }
    if constexpr (K == 13) { pg8::Gemm g{U, (const bf16*)(ws + WS_W13B), MROWS, 2 * FF, D, D}; pg8::StaticOrder S; S.init(MROWS, 2 * FF, F.G, F.bid); EpiSwiGLU E{H}; GEMM_PHASE(EpiSwiGLU, g, S, E); }
    if constexpr (K == 14) { pg8::Gemm g{H, (const bf16*)(ws + WS_W2B), MROWS, D, FF, FF}; pg8::StaticOrder S; S.init(MROWS, D, F.G, F.bid, 192); EpiResid<3> E{X, X + (size_t)NCTX * D, X, mod + 8 * D, 0.5f}; GEMM_PHASE3(EpiResid<3>, g, S, E); }
    if constexpr (K == 15) { final_norm_phase(a, F); }
}
#ifndef PROGRAM
#define PROGRAM P(0) P(1) P(2) P(3) P(4) P(5) P(6) P(7) P(8) P(9) P(10) P(11) P(12) P(13) P(14) L(15)
#endif
__global__ void __launch_bounds__(512, 2) fwd_kernel(Args a) {
    extern __shared__ __attribute__((aligned(16))) unsigned char lds[];
    Frame F; F.lds = lds; F.tid = threadIdx.x; F.lane = F.tid & 63; F.wave = __builtin_amdgcn_readfirstlane(F.tid >> 6);
    F.G = gridDim.x; F.bid = blockIdx.x; F.gw = F.bid * 8 + F.wave; F.ngw = F.G * 8;
    volatile LAS unsigned* MISC = (volatile LAS unsigned*)((LAS unsigned char*)lds + MISC_OFF);
    if (F.tid < 64) MISC[F.tid] = 0u;
    __syncthreads();
    XcdBarrier bar = xcd_barrier_post((unsigned*)(a.ws + WS_CTL) + CW_BAR, MISC + 8);
#ifdef DOUBLE_BAR
#define P(k) run_phase<k>(a, F, (LAS unsigned char*)lds); xcd_barrier(bar); xcd_barrier(bar);
#else
#define P(k) run_phase<k>(a, F, (LAS unsigned char*)lds); xcd_barrier(bar);
#endif
#define L(k) run_phase<k>(a, F, (LAS unsigned char*)lds);
    PROGRAM
#undef P
#undef L
}

extern "C" void kernel_launch(void* const* d_in, const int* in_sizes, int n_in, void* d_out, int out_size, void* d_ws, size_t ws_size, hipStream_t stream) {
    static int grid = 0;
    if (grid == 0) {
        if (n_in != 31 || (size_t)out_size != OUT_END || ws_size < WS_END) { fprintf(stderr, "kernel_launch: unexpected shapes: n_in %d out %d ws %zu\n", n_in, out_size, ws_size); grid = -1; return; }
        int dev = 0, cus = 0, per_cu = 0;
        if (hipGetDevice(&dev) != hipSuccess || hipDeviceGetAttribute(&cus, hipDeviceAttributeMultiprocessorCount, dev) != hipSuccess) { grid = -1; return; }
        if (hipFuncSetAttribute((const void*)fwd_kernel, hipFuncAttributeMaxDynamicSharedMemorySize, LDS_BYTES) != hipSuccess) { fprintf(stderr, "kernel_launch: hipFuncSetAttribute failed\n"); grid = -1; return; }
        if (hipOccupancyMaxActiveBlocksPerMultiprocessor(&per_cu, (const void*)fwd_kernel, 512, LDS_BYTES) != hipSuccess || per_cu < 1) { fprintf(stderr, "kernel_launch: occupancy query says %d blocks per CU\n", per_cu); grid = -1; return; }
        (void)hipGetLastError();
        grid = cus * 1;
    }
    if (grid < 0) return;
    (void)hipMemsetAsync((char*)d_ws + WS_CTL, 0, CTL_ZERO_BYTES, stream);
    Args a{};
    for (int i = 0; i < 31; ++i) a.in[i] = (const float*)d_in[i];
    a.out = (float*)d_out; a.ws = (unsigned char*)d_ws;
    a.ph_lo = 0; a.ph_hi = NPHASE;
    void* args[] = {&a};
    hipError_t e = hipLaunchCooperativeKernel((const void*)fwd_kernel, dim3(grid), dim3(512), args, LDS_BYTES, stream);
    if (e != hipSuccess) fprintf(stderr, "kernel_launch: cooperative launch failed: %s (grid %d)\n", hipGetErrorString(e), grid);
}
```
